# Optimizing an MI355X kernel written in HIP

```python
import math
import jax, jax.numpy as jnp
from jax import lax
import numpy as np

D_MODEL = 1024
BATCH = 1
SEQ = 16384
DEPTH = 2

GRID_W = 64
CTX_LEN = 256
HEAD_DIM = 64
MIX_WIDTH = D_MODEL
NA_WIDTH = MIX_WIDTH // 4
NA_HEADS = NA_WIDTH // HEAD_DIM
NA_WIN_ROWS = 8
NA_WIN_COLS = 16
SSD_WIDTH = MIX_WIDTH // 2
SSD_HEADDIM = 64
SSD_HEADS = SSD_WIDTH // SSD_HEADDIM
SSD_GROUPS = 2
SSD_HEADS_PER_GROUP = SSD_HEADS // SSD_GROUPS
SSD_STATE = 128
SSD_CONV = 5
SSD_CHUNK = 128
SSD_CONV_CH = SSD_WIDTH + 2 * SSD_GROUPS * SSD_STATE
GQA_WIDTH = MIX_WIDTH - NA_WIDTH - SSD_WIDTH
GQA_Q_HEADS = GQA_WIDTH // HEAD_DIM
GQA_KV_HEADS = GQA_Q_HEADS // 2
GQA_REP = GQA_Q_HEADS // GQA_KV_HEADS
Q_BLOCK = 128
ROPE_THETA = 10000.0
ROPE_PAIRS = HEAD_DIM // 4
NA_IN = 3 * NA_WIDTH
SSD_IN = SSD_WIDTH + SSD_CONV_CH + 2 * SSD_HEADS
GQA_IN = GQA_WIDTH + 2 * GQA_KV_HEADS * HEAD_DIM
IN_WIDTH = NA_IN + SSD_IN + GQA_IN
FFN_HIDDEN = -(-(8 * D_MODEL) // (3 * 256)) * 256
EPS = 1e-6

kernel_name = 'hybrid_na_ssd_gqa_dit_block'


def rms_norm(x, w):
    xf = x.astype(jnp.float32)
    y = xf * lax.rsqrt(jnp.mean(xf * xf, axis=-1, keepdims=True) + EPS)
    return y.astype(x.dtype) * w


def axial_rope(x, rows, cols):
    freqs = ROPE_THETA ** (-jnp.arange(ROPE_PAIRS, dtype=jnp.float32) / ROPE_PAIRS)

    def rotate(xh, pos):
        ang = pos[:, None] * freqs[None, :]
        ang = jnp.concatenate([ang, ang], axis=-1)[None, :, None, :]
        cos = jnp.cos(ang).astype(xh.dtype)
        sin = jnp.sin(ang).astype(xh.dtype)
        x1, x2 = jnp.split(xh, 2, axis=-1)
        return xh * cos + jnp.concatenate([-x2, x1], axis=-1) * sin

    half = HEAD_DIM // 2
    return jnp.concatenate([rotate(x[..., :half], rows), rotate(x[..., half:], cols)], axis=-1)


def gqa_softmax_attention(q, k, v):
    s = jnp.einsum('bqgrd,bkgd->bgrqk', q, k) * (HEAD_DIM ** -0.5)
    p = jax.nn.softmax(s.astype(jnp.float32), axis=-1).astype(v.dtype)
    return jnp.einsum('bgrqk,bkgd->bqgrd', p, v)


def neighbourhood_attention(u, u_c, rpb, ctx_out):
    b, l, _ = u.shape
    lc = u_c.shape[1]
    rows = l // GRID_W
    wh = min(NA_WIN_ROWS, rows)
    q, k, v = [t.reshape(b, rows, GRID_W, NA_HEADS, HEAD_DIM) for t in jnp.split(u, 3, axis=-1)]
    qc, kc, vc = [t.reshape(b, lc, NA_HEADS, HEAD_DIM) for t in jnp.split(u_c, 3, axis=-1)]
    scale = HEAD_DIM ** -0.5
    r = jnp.arange(rows)
    col = jnp.arange(GRID_W)
    r_start = jnp.clip(r - wh // 2, 0, rows - wh)
    rows_idx = r_start[:, None] + jnp.arange(wh)[None, :]
    c_start = jnp.clip(col - NA_WIN_COLS // 2, 0, GRID_W - NA_WIN_COLS)
    in_win = (col[None, :] >= c_start[:, None]) & (col[None, :] < c_start[:, None] + NA_WIN_COLS)
    dr = rows_idx - r[:, None] + NA_WIN_ROWS - 1
    dc = jnp.clip(col[None, :] - col[:, None] + NA_WIN_COLS - 1, 0, 2 * NA_WIN_COLS - 2)
    bias = rpb[:, dr[:, None, :, None], dc[None, :, None, :]].transpose(1, 0, 2, 3, 4)
    kb = k[:, rows_idx]
    vb = v[:, rows_idx]
    s_win = jnp.einsum('brqhd,brswhd->brhqsw', q, kb) * scale + bias[None]
    s_win = jnp.where(in_win[:, None, :], s_win, -jnp.inf)
    s_ctx = jnp.einsum('brqhd,bkhd->brhqk', q, kc) * scale
    n_win = wh * GRID_W
    s = jnp.concatenate([s_win.reshape(b, rows, NA_HEADS, GRID_W, n_win), s_ctx], axis=-1)
    p = jax.nn.softmax(s.astype(jnp.float32), axis=-1).astype(v.dtype)
    p_win = p[..., :n_win].reshape(b, rows, NA_HEADS, GRID_W, wh, GRID_W)
    p_ctx = p[..., n_win:]
    y = jnp.einsum('brhqsw,brswhd->brqhd', p_win, vb) + jnp.einsum('brhqk,bkhd->brqhd', p_ctx, vc)
    y = y.reshape(b, l, NA_WIDTH)
    y_c = None
    if ctx_out:
        y_c = gqa_softmax_attention(qc[:, :, :, None, :], kc, vc).reshape(b, lc, NA_WIDTH)
    return y, y_c


def depthwise_conv(x, w, bias):
    y = lax.conv_general_dilated(x, w[:, None, :], window_strides=(1,),
                                 padding=[(SSD_CONV // 2, SSD_CONV // 2)],
                                 dimension_numbers=('NWC', 'WIO', 'NWC'),
                                 feature_group_count=x.shape[-1])
    return y + bias


def ssd_scan(xs, dt, a, bm, cm, h0):
    b, l, h, p = xs.shape
    n = bm.shape[-1]
    nc = l // SSD_CHUNK
    xr = (xs * dt[..., None]).reshape(b, nc, SSD_CHUNK, h, p)
    br = bm.reshape(b, nc, SSD_CHUNK, h, n)
    cr = cm.reshape(b, nc, SSD_CHUNK, h, n)
    a_cum = jnp.cumsum((dt * a).reshape(b, nc, SSD_CHUNK, h), axis=2)
    seg = a_cum[:, :, :, None, :] - a_cum[:, :, None, :, :]
    causal = jnp.tril(jnp.ones((SSD_CHUNK, SSD_CHUNK), dtype=bool))[None, None, :, :, None]
    decay = jnp.exp(jnp.where(causal, seg, -jnp.inf))
    g = jnp.einsum('bcthn,bcshn->bctsh', cr, br) * decay
    y_diag = jnp.einsum('bctsh,bcshp->bcthp', g, xr)
    to_end = jnp.exp(a_cum[:, :, -1:, :] - a_cum)
    chunk_states = jnp.einsum('bcsh,bcshn,bcshp->bchpn', to_end, br, xr)
    chunk_decay = jnp.exp(a_cum[:, :, -1, :])

    def step(h_prev, inp):
        dec, st = inp
        return dec[:, :, None, None] * h_prev + st, h_prev

    h_final, h_enter = lax.scan(step, h0, (chunk_decay.transpose(1, 0, 2),
                                           chunk_states.transpose(1, 0, 2, 3, 4)))
    h_enter = h_enter.transpose(1, 0, 2, 3, 4)
    y_off = jnp.einsum('bcthn,bcth,bchpn->bcthp', cr, jnp.exp(a_cum), h_enter)
    return (y_diag + y_off).reshape(b, l, h, p), h_final


def ssd_mixer(u, u_c, conv_w, conv_b, dt_bias, a_log, d_skip, norm_w, ctx_out):
    f32 = jnp.float32
    a = -jnp.exp(a_log.astype(f32))

    def prep(v):
        b, l, _ = v.shape
        z, xbc, dt_raw = jnp.split(v, [SSD_WIDTH, SSD_WIDTH + SSD_CONV_CH], axis=-1)
        xbc = jax.nn.silu(depthwise_conv(xbc, conv_w, conv_b))
        xs, bm, cm = jnp.split(xbc, [SSD_WIDTH, SSD_WIDTH + SSD_GROUPS * SSD_STATE], axis=-1)
        xs = xs.reshape(b, l, SSD_HEADS, SSD_HEADDIM).astype(f32)
        bm = jnp.repeat(bm.reshape(b, l, SSD_GROUPS, SSD_STATE), SSD_HEADS_PER_GROUP, axis=2).astype(f32)
        cm = jnp.repeat(cm.reshape(b, l, SSD_GROUPS, SSD_STATE), SSD_HEADS_PER_GROUP, axis=2).astype(f32)
        dt = jax.nn.softplus(dt_raw.reshape(b, l, 2, SSD_HEADS).astype(f32) + dt_bias.astype(f32))
        return z, xs, bm, cm, dt

    def flip(t):
        return jnp.flip(t, axis=1)

    z, xs, bm, cm, dt = prep(u)
    zc, xsc, bmc, cmc, dtc = prep(u_c)
    h0 = jnp.zeros((u.shape[0], SSD_HEADS, SSD_HEADDIM, SSD_STATE), f32)
    yc_f, hc_f = ssd_scan(xsc, dtc[:, :, 0], a[0], bmc, cmc, h0)
    yc_b, hc_b = ssd_scan(flip(xsc), flip(dtc[:, :, 1]), a[1], flip(bmc), flip(cmc), h0)
    y_f, _ = ssd_scan(xs, dt[:, :, 0], a[0], bm, cm, hc_f)
    y_b, _ = ssd_scan(flip(xs), flip(dt[:, :, 1]), a[1], flip(bm), flip(cm), hc_b)

    def finish(yf, yb_flipped, xsd, zz):
        y = yf + flip(yb_flipped) + d_skip.astype(f32)[:, None] * xsd
        y = y.reshape(zz.shape).astype(zz.dtype) * jax.nn.silu(zz)
        return rms_norm(y, norm_w)

    y = finish(y_f, y_b, xs, z)
    y_c = finish(yc_f, yc_b, xsc, zc) if ctx_out else None
    return y, y_c


def gqa_attention(u, u_c, q_norm_w, k_norm_w, ctx_out):
    b, l, _ = u.shape
    lc = u_c.shape[1]
    kv_w = GQA_KV_HEADS * HEAD_DIM

    def prep(v, n):
        q, k, vv = jnp.split(v, [GQA_WIDTH, GQA_WIDTH + kv_w], axis=-1)
        q = rms_norm(q.reshape(b, n, GQA_Q_HEADS, HEAD_DIM), q_norm_w)
        k = rms_norm(k.reshape(b, n, GQA_KV_HEADS, HEAD_DIM), k_norm_w)
        return q, k, vv.reshape(b, n, GQA_KV_HEADS, HEAD_DIM)

    q, k, v = prep(u, l)
    qc, kc, vc = prep(u_c, lc)
    t = jnp.arange(l)
    rows = (t // GRID_W).astype(jnp.float32)
    cols = (t % GRID_W).astype(jnp.float32)
    q = axial_rope(q, rows, cols)
    k = axial_rope(k, rows, cols)
    k_all = jnp.concatenate([k, kc], axis=1)
    v_all = jnp.concatenate([v, vc], axis=1)
    nb = l // Q_BLOCK
    qb = q.reshape(b, nb, Q_BLOCK, GQA_KV_HEADS, GQA_REP, HEAD_DIM).transpose(1, 0, 2, 3, 4, 5)
    o = lax.map(lambda qi: gqa_softmax_attention(qi, k_all, v_all), qb)
    y = o.transpose(1, 0, 2, 3, 4, 5).reshape(b, l, GQA_WIDTH)
    y_c = None
    if ctx_out:
        qcg = qc.reshape(b, lc, GQA_KV_HEADS, GQA_REP, HEAD_DIM)
        y_c = gqa_softmax_attention(qcg, kc, vc).reshape(b, lc, GQA_WIDTH)
    return y, y_c


def swiglu(h, w_gate, w_up, w_down):
    return (jax.nn.silu(h @ w_gate) * (h @ w_up)) @ w_down


def setup_inputs(seed: int = 0) -> dict:
    key = jax.random.key(seed)
    ks = jax.random.split(key, 26)
    f32 = jnp.float32
    L = DEPTH

    def nrm(k, shape, scale):
        return jax.random.normal(k, shape, f32) * scale

    dt0 = jnp.exp(jax.random.uniform(ks[12], (L, 2, SSD_HEADS), f32, math.log(1e-3), math.log(1e-1)))
    return {
        'x': nrm(ks[0], (BATCH, SEQ, D_MODEL), 1.0),
        'c': nrm(ks[1], (BATCH, D_MODEL), 1.0),
        'ctx': nrm(ks[2], (BATCH, CTX_LEN, D_MODEL), 1.0),
        'c_ctx': nrm(ks[3], (D_MODEL,), 1.0),
        'mod_w': nrm(ks[4], (L, D_MODEL, 6 * D_MODEL), 0.5 * D_MODEL ** -0.5),
        'mod_b': nrm(ks[5], (L, 6 * D_MODEL), 0.01),
        'norm_attn_w': 1.0 + nrm(ks[6], (L, D_MODEL), 0.05),
        'norm_ffn_w': 1.0 + nrm(ks[7], (L, D_MODEL), 0.05),
        'w_in': nrm(ks[8], (L, D_MODEL, IN_WIDTH), D_MODEL ** -0.5),
        'na_rpb': nrm(ks[9], (L, NA_HEADS, 2 * NA_WIN_ROWS - 1, 2 * NA_WIN_COLS - 1), 0.1),
        'ssd_conv_w': nrm(ks[10], (L, SSD_CONV, SSD_CONV_CH), SSD_CONV ** -0.5),
        'ssd_conv_b': nrm(ks[11], (L, SSD_CONV_CH), 0.01),
        'ssd_dt_bias': dt0 + jnp.log(-jnp.expm1(-dt0)),
        'ssd_a_log': jnp.log(jax.random.uniform(ks[13], (L, 2, SSD_HEADS), f32, 1.0, 16.0)),
        'ssd_d': 1.0 + nrm(ks[14], (L, SSD_HEADS), 0.05),
        'ssd_norm_w': 1.0 + nrm(ks[15], (L, SSD_WIDTH), 0.05),
        'q_norm_w': 1.0 + nrm(ks[16], (L, HEAD_DIM), 0.05),
        'k_norm_w': 1.0 + nrm(ks[17], (L, HEAD_DIM), 0.05),
        'w_out': nrm(ks[18], (L, MIX_WIDTH, D_MODEL), MIX_WIDTH ** -0.5),
        'ffn_w_gate': nrm(ks[19], (L, D_MODEL, FFN_HIDDEN), D_MODEL ** -0.5),
        'ffn_w_up': nrm(ks[20], (L, D_MODEL, FFN_HIDDEN), D_MODEL ** -0.5),
        'ffn_w_down': nrm(ks[21], (L, FFN_HIDDEN, D_MODEL), FFN_HIDDEN ** -0.5),
        'final_norm_w': 1.0 + nrm(ks[22], (D_MODEL,), 0.05),
    }


def reference(x, c, ctx, c_ctx, mod_w, mod_b, norm_attn_w, norm_ffn_w, w_in, na_rpb,
              ssd_conv_w, ssd_conv_b, ssd_dt_bias, ssd_a_log, ssd_d, ssd_norm_w,
              q_norm_w, k_norm_w, w_out, ffn_w_gate, ffn_w_up, ffn_w_down, final_norm_w):
    cx = ctx
    splits = [NA_IN, NA_IN + SSD_IN]
    for i in range(DEPTH):
        ctx_out = i < DEPTH - 1
        mod = (jax.nn.silu(c) @ mod_w[i] + mod_b[i])[:, None, :]
        mod_c = (jax.nn.silu(c_ctx) @ mod_w[i] + mod_b[i])[None, None, :]
        sh_m, sc_m, g_m, sh_f, sc_f, g_f = jnp.split(mod, 6, axis=-1)
        csh_m, csc_m, cg_m, csh_f, csc_f, cg_f = jnp.split(mod_c, 6, axis=-1)
        h = rms_norm(x, norm_attn_w[i]) * (1.0 + sc_m) + sh_m
        hc = rms_norm(cx, norm_attn_w[i]) * (1.0 + csc_m) + csh_m
        ua, ub, ug = jnp.split(h @ w_in[i], splits, axis=-1)
        uca, ucb, ucg = jnp.split(hc @ w_in[i], splits, axis=-1)
        ya, yca = neighbourhood_attention(ua, uca, na_rpb[i], ctx_out)
        yb, ycb = ssd_mixer(ub, ucb, ssd_conv_w[i], ssd_conv_b[i], ssd_dt_bias[i], ssd_a_log[i],
                            ssd_d[i], ssd_norm_w[i], ctx_out)
        yg, ycg = gqa_attention(ug, ucg, q_norm_w[i], k_norm_w[i], ctx_out)
        x = x + g_m * (jnp.concatenate([ya, yb, yg], axis=-1) @ w_out[i])
        hf = rms_norm(x, norm_ffn_w[i]) * (1.0 + sc_f) + sh_f
        x = x + g_f * swiglu(hf, ffn_w_gate[i], ffn_w_up[i], ffn_w_down[i])
        if ctx_out:
            cx = cx + cg_m * (jnp.concatenate([yca, ycb, ycg], axis=-1) @ w_out[i])
            hcf = rms_norm(cx, norm_ffn_w[i]) * (1.0 + csc_f) + csh_f
            cx = cx + cg_f * swiglu(hcf, ffn_w_gate[i], ffn_w_up[i], ffn_w_down[i])
    return rms_norm(x, final_norm_w)
```

```cpp
#include <hip/hip_runtime.h>
#include <hip/hip_cooperative_groups.h>
#include <cstdio>
#include <cstdint>
namespace cg = cooperative_groups;

#ifndef MULTI_LAUNCH
#define MULTI_LAUNCH 0
#endif

#define DI __device__ __forceinline__
typedef unsigned short bf16_t;
typedef short bf16x8 __attribute__((ext_vector_type(8)));
typedef short bf16x4 __attribute__((ext_vector_type(4)));
typedef float f32x16 __attribute__((ext_vector_type(16)));
typedef float f32x4 __attribute__((ext_vector_type(4)));
typedef float f32x2 __attribute__((ext_vector_type(2)));
typedef unsigned u32x4 __attribute__((ext_vector_type(4)));
typedef unsigned u32x2 __attribute__((ext_vector_type(2)));
typedef __bf16 bf16v2 __attribute__((ext_vector_type(2)));

#define MFMA32(a, b, c) __builtin_amdgcn_mfma_f32_32x32x16_bf16((a), (b), (c), 0, 0, 0)
#define MFMA16(a, b, c) __builtin_amdgcn_mfma_f32_16x16x32_bf16((a), (b), (c), 0, 0, 0)

constexpr int L_ = 16384, LC_ = 256, T_ = 16640, DM = 1024, NIN = 2832, NINP = 2944, FH = 2816, NCH = 130;
constexpr int NT = 256;
constexpr float EPSF = 1e-6f;
constexpr float LOG2E = 1.4426950408889634f;
constexpr int SMEM_BYTES = 73728;

constexpr size_t al256(size_t x) { return (x + 255) & ~(size_t)255; }
constexpr size_t OFF_WIN = 0;
constexpr size_t OFF_WOUT = OFF_WIN + al256((size_t)NINP * DM * 2);
constexpr size_t OFF_WGU = OFF_WOUT + al256((size_t)DM * DM * 2);
constexpr size_t OFF_WD = OFF_WGU + al256((size_t)2 * FH * DM * 2);
constexpr size_t OFF_MOD = OFF_WD + al256((size_t)DM * FH * 2);
constexpr size_t OFF_ROPE = OFF_MOD + al256((size_t)2 * 2 * 6144 * 4);
constexpr size_t OFF_XC = OFF_ROPE + al256((size_t)256 * 16 * 8);
constexpr size_t OFF_A1 = OFF_XC + al256((size_t)LC_ * DM * 4);
constexpr size_t OFF_U = OFF_A1 + al256((size_t)T_ * DM * 2);
constexpr size_t OFF_DTRAW = OFF_U + al256((size_t)T_ * NIN * 2);
constexpr size_t OFF_DT = OFF_DTRAW + al256((size_t)T_ * 16 * 4);
constexpr size_t OFF_ACUM = OFF_DT + al256((size_t)T_ * 16 * 4);
constexpr size_t OFF_XBT = OFF_ACUM + al256((size_t)T_ * 16 * 4);
constexpr size_t OFF_BC = OFF_XBT + al256((size_t)NCH * 768 * 128 * 2);
constexpr size_t OFF_QG = OFF_BC + al256((size_t)T_ * 512 * 2);
constexpr size_t OFF_KG = OFF_QG + al256((size_t)T_ * 256 * 2);
constexpr size_t OFF_VGT = OFF_KG + al256((size_t)T_ * 128 * 2);
constexpr size_t OFF_VNT = OFF_VGT + al256((size_t)T_ * 128 * 2);
constexpr size_t OFF_ST = OFF_VNT + al256((size_t)T_ * 256 * 2);
constexpr size_t OFF_CDEC = OFF_ST + al256((size_t)16 * NCH * 8192 * 2);
constexpr size_t OFF_SSQ = OFF_CDEC + al256((size_t)16 * NCH * 4);
constexpr size_t OFF_BAR = OFF_SSQ + al256((size_t)T_ * 4);
constexpr size_t WS_TOTAL = OFF_BAR + 64 * 256;
static_assert(WS_TOTAL <= (size_t)256 * 1024 * 1024, "workspace too large");

struct Params {
  const float *x, *c, *ctx, *c_ctx, *mod_w, *mod_b, *norm_attn_w, *norm_ffn_w, *w_in, *na_rpb, *conv_w, *conv_b, *dt_bias, *a_log,
      *ssd_d, *ssd_norm_w, *q_norm_w, *k_norm_w, *w_out, *w_gate, *w_up, *w_down, *final_norm_w;
  float* out;
  char* ws;
};

DI unsigned pack2(float lo, float hi) { f32x2 v = {lo, hi}; return __builtin_bit_cast(unsigned, __builtin_convertvector(v, bf16v2)); }
DI bf16_t f2bf(float x) { return (bf16_t)(pack2(x, 0.f) & 0xffffu); }
DI float bf2f(bf16_t v) { return __uint_as_float(((unsigned)v) << 16); }
DI float bflo(unsigned u) { return __uint_as_float(u << 16); }
DI float bfhi(unsigned u) { return __uint_as_float(u & 0xffff0000u); }
DI int crow(int reg, int hh) { return (reg & 3) + 8 * (reg >> 2) + 4 * hh; }
DI float siluf(float x) { return x * __builtin_amdgcn_rcpf(1.f + __expf(-x)); }
DI f32x16 zero16() { f32x16 z; for (int i = 0; i < 16; ++i) z[i] = 0.f; return z; }
template <int S> DI bf16x8 pack8(const f32x16& x) {
  u32x4 p;
  p[0] = pack2(x[8 * S + 0], x[8 * S + 1]); p[1] = pack2(x[8 * S + 2], x[8 * S + 3]);
  p[2] = pack2(x[8 * S + 4], x[8 * S + 5]); p[3] = pack2(x[8 * S + 6], x[8 * S + 7]);
  return __builtin_bit_cast(bf16x8, p);
}
DI bf16x8 cat44(u32x2 lo, u32x2 hi) { u32x4 p = {lo[0], lo[1], hi[0], hi[1]}; return __builtin_bit_cast(bf16x8, p); }
DI float shx(float v, int mask, int lane) { return __int_as_float(__builtin_amdgcn_ds_bpermute((lane ^ mask) << 2, __float_as_int(v))); }
DI float wave_sum(float v, int lane) {
#pragma unroll
  for (int o = 32; o > 0; o >>= 1) v += shx(v, o, lane);
  return v;
}

DI void mod_item(int tix, const Params& p, int it, char* smem) {
  const int tid = tix, layer = it / 96, cg64 = it % 96, col = tid & 63, kq = tid >> 6;
  const float* W = p.mod_w + (size_t)layer * DM * 6144 + cg64 * 64 + col;
  float* sc = (float*)smem;
  float* red = sc + 2048;
  __syncthreads();
  for (int i = tid; i < 1024; i += NT) { sc[i] = siluf(p.c[i]); sc[1024 + i] = siluf(p.c_ctx[i]); }
  __syncthreads();
  float a0 = 0.f, a1 = 0.f;
#pragma unroll 1
  for (int k0 = kq * 256; k0 < kq * 256 + 256; k0 += 16) {
    float w[16];
#pragma unroll
    for (int j = 0; j < 16; ++j) w[j] = W[(size_t)(k0 + j) * 6144];
#pragma unroll
    for (int j = 0; j < 16; ++j) { a0 += sc[k0 + j] * w[j]; a1 += sc[1024 + k0 + j] * w[j]; }
  }
  red[(0 * 4 + kq) * 64 + col] = a0; red[(1 * 4 + kq) * 64 + col] = a1;
  __syncthreads();
  if (tid < 128) {
    const int src = tid >> 6;
    float s = red[(src * 4 + 0) * 64 + col] + red[(src * 4 + 1) * 64 + col] + red[(src * 4 + 2) * 64 + col] + red[(src * 4 + 3) * 64 + col];
    s += p.mod_b[layer * 6144 + cg64 * 64 + col];
    float* MOD = (float*)(p.ws + OFF_MOD);
    MOD[(layer * 2 + src) * 6144 + cg64 * 64 + col] = s;
  }
}
DI void rope_item(int tix, const Params& p, int it) {
  const int e = it * NT + tix;
  const int pos = e >> 4, j = e & 15;
  const double freq = exp2(-(double)j * (13.287712379549449 / 16.0));
  double rv = (double)pos * freq * 0.15915494309189535;
  rv -= floor(rv);
  const float fr = (float)rv;
  f32x2* R = (f32x2*)(p.ws + OFF_ROPE);
  f32x2 cs = {__builtin_amdgcn_cosf(fr), __builtin_amdgcn_sinf(fr)};
  R[e] = cs;
}

DI void wconv_tile(int tix, const float* __restrict__ src0, const float* __restrict__ src1, int ldsrc, int ncols_valid, bf16_t* __restrict__ dst, int K,
                   int nt, int kt, int mode, char* smem) {
  float* tile = (float*)smem;
  const int tid = tix, cn = tid & 63, rq = tid >> 6;
  __syncthreads();
  for (int i = 0; i < 16; ++i) {
    const int k = i * 4 + rq;
    float v;
    if (mode == 0) { const int n = nt * 64 + cn; v = (n < ncols_valid) ? src0[(size_t)(kt * 64 + k) * ldsrc + n] : 0.f; }
    else { const int unit = nt * 32 + (cn & 31); v = ((cn >> 5) ? src1 : src0)[(size_t)(kt * 64 + k) * ldsrc + unit]; }
    tile[k * 65 + cn] = v;
  }
  __syncthreads();
  for (int i = 0; i < 16; ++i) {
    const int n = i * 4 + rq, k = cn;
    dst[(size_t)(nt * 64 + n) * K + kt * 64 + k] = f2bf(tile[k * 65 + n]);
  }
}
constexpr int WC_IN = 46 * 16, WC_OUT = 16 * 16, WC_GU = 88 * 16, WC_D = 16 * 44, WC_TOTAL = WC_IN + WC_OUT + WC_GU + WC_D;
DI void wconv_item(int tix, const Params& p, int layer, int it, char* smem) {
  if (it < WC_IN) { wconv_tile(tix, p.w_in + (size_t)layer * DM * NIN, nullptr, NIN, NIN, (bf16_t*)(p.ws + OFF_WIN), DM, it / 16, it % 16, 0, smem); return; }
  it -= WC_IN;
  if (it < WC_OUT) { wconv_tile(tix, p.w_out + (size_t)layer * DM * DM, nullptr, DM, DM, (bf16_t*)(p.ws + OFF_WOUT), DM, it / 16, it % 16, 0, smem); return; }
  it -= WC_OUT;
  if (it < WC_GU) { wconv_tile(tix, p.w_gate + (size_t)layer * DM * FH, p.w_up + (size_t)layer * DM * FH, FH, FH, (bf16_t*)(p.ws + OFF_WGU), DM, it / 16, it % 16, 1, smem); return; }
  it -= WC_GU;
  wconv_tile(tix, p.w_down + (size_t)layer * FH * DM, nullptr, DM, DM, (bf16_t*)(p.ws + OFF_WD), FH, it / 44, it % 44, 0, smem);
}

DI void norm_rows(int tix0, const Params& p, int layer, int which, int bid, int nb, int nitems) {
  int tix = tix0; asm volatile("" : "+v"(tix));
  const int lane = tix & 63, wid = tix >> 6;
  const float* MOD = (const float*)(p.ws + OFF_MOD);
  const float* XC = (const float*)(p.ws + OFF_XC);
  bf16_t* A1 = (bf16_t*)(p.ws + OFF_A1);
  const bool from_in = (layer == 0 && which == 0);
  const float* lat_base = from_in ? p.x : p.out;
  const float* ctx_base = (from_in ? p.ctx : XC) - (size_t)L_ * DM;
  auto rowsrc = [&](int row) -> const float* { return (row < L_ ? lat_base : ctx_base) + (size_t)row * DM; };
  f32x4 vc[2][4], vn[2][4];
  auto ld = [&](int it, f32x4 (&v)[2][4]) {
#pragma unroll
    for (int rr = 0; rr < 2; ++rr) {
      const float* src = rowsrc(it * 8 + wid * 2 + rr);
#pragma unroll
      for (int i = 0; i < 4; ++i) v[rr][i] = *(const f32x4*)(src + i * 256 + lane * 4);
    }
  };
  int it = bid;
  if (it < nitems) ld(it, vc);
  for (; it < nitems; it += nb) {
    const bool more = it + nb < nitems;
    if (more) ld(it + nb, vn);
    __builtin_amdgcn_sched_barrier(0);
#pragma unroll
    for (int rr = 0; rr < 2; ++rr) {
      const int row = it * 8 + wid * 2 + rr;
      float ss = 0.f;
#pragma unroll
      for (int i = 0; i < 4; ++i) ss += vc[rr][i][0] * vc[rr][i][0] + vc[rr][i][1] * vc[rr][i][1] + vc[rr][i][2] * vc[rr][i][2] + vc[rr][i][3] * vc[rr][i][3];
      ss = wave_sum(ss, lane);
      const float rstd = rsqrtf(ss * (1.f / DM) + EPSF);
      if (which == 2) {
        float* dst = p.out + (size_t)row * DM;
#pragma unroll
        for (int i = 0; i < 4; ++i) {
          const f32x4 w = *(const f32x4*)(p.final_norm_w + i * 256 + lane * 4);
          f32x4 o; for (int j = 0; j < 4; ++j) o[j] = vc[rr][i][j] * rstd * w[j];
          *(f32x4*)(dst + i * 256 + lane * 4) = o;
        }
      } else {
        const float* nw = (which == 0 ? p.norm_attn_w : p.norm_ffn_w) + layer * DM;
        const float* md = MOD + (layer * 2 + (row >= L_ ? 1 : 0)) * 6144 + (which == 0 ? 0 : 3 * DM);
#pragma unroll
        for (int i = 0; i < 4; ++i) {
          const int c = i * 256 + lane * 4;
          const f32x4 w = *(const f32x4*)(nw + c), sh = *(const f32x4*)(md + c), sc = *(const f32x4*)(md + DM + c);
          float o[4]; for (int j = 0; j < 4; ++j) o[j] = vc[rr][i][j] * rstd * w[j] * (1.f + sc[j]) + sh[j];
          u32x2 pk = {pack2(o[0], o[1]), pack2(o[2], o[3])};
          *(u32x2*)(A1 + (size_t)row * DM + c) = pk;
        }
      }
    }
    if (more) {
#pragma unroll
      for (int rr = 0; rr < 2; ++rr)
#pragma unroll
        for (int i = 0; i < 4; ++i) vc[rr][i] = vn[rr][i];
    }
  }
}

template <bool SCALE_A, bool NOLOAD = false, class Epi>
DI void gemm_tile(int tix, const float* __restrict__ SSQ, const bf16_t* __restrict__ A, int lda, const bf16_t* __restrict__ Bt, int ldb, int K, int m0, int n0, char* smem, const Epi& epi, int kbeg = 0) {
  const int tid = tix, lane = tid & 63, wid = tid >> 6, wr = wid >> 1, wc = wid & 1, fr = lane & 15, fq = lane >> 4;
  bf16_t* sbuf = (bf16_t*)smem;
  constexpr int STG = 2 * 128 * 72;
  f32x4 acc[4][4];
#pragma unroll
  for (int mi = 0; mi < 4; ++mi)
#pragma unroll
    for (int ni = 0; ni < 4; ++ni) acc[mi][ni] = (f32x4){0.f, 0.f, 0.f, 0.f};
  const int lrow = tid >> 3, lcol = (tid & 7) * 8;
  const bf16_t* ga = A + (size_t)(m0 + lrow) * lda + lcol + kbeg;
  const bf16_t* gb = Bt + (size_t)(n0 + lrow) * ldb + lcol + kbeg;
  float rs[4] = {1.f, 1.f, 1.f, 1.f};
  if (SCALE_A) {
#pragma unroll
    for (int i = 0; i < 4; ++i) rs[i] = rsqrtf(SSQ[m0 + lrow + 32 * i] * (1.f / 512.f) + EPSF);
  }
  u32x4 ra[4], rb[4];
  auto gload = [&](int k0) {
#pragma unroll
    for (int i = 0; i < 4; ++i) { ra[i] = *(const u32x4*)(ga + (size_t)(32 * i) * lda + k0); rb[i] = *(const u32x4*)(gb + (size_t)(32 * i) * ldb + k0); }
  };
  auto lstore = [&](int stage, int k0) {
    if (SCALE_A && kbeg + k0 >= 256 && kbeg + k0 < 768) {
#pragma unroll
      for (int i = 0; i < 4; ++i)
#pragma unroll
        for (int q = 0; q < 4; ++q) ra[i][q] = pack2(bflo(ra[i][q]) * rs[i], bfhi(ra[i][q]) * rs[i]);
    }
    bf16_t* sA = sbuf + stage * STG; bf16_t* sB = sA + 128 * 72;
#pragma unroll
    for (int i = 0; i < 4; ++i) { *(u32x4*)(sA + (lrow + 32 * i) * 72 + lcol) = ra[i]; *(u32x4*)(sB + (lrow + 32 * i) * 72 + lcol) = rb[i]; }
  };
  const int nk = K >> 6;
  gload(0);
  __syncthreads();
  lstore(0, 0);
  if (nk > 1) gload(64);
  __syncthreads();
  for (int kt = 0; kt < nk; ++kt) {
    const int cur = kt & 1;
    if (kt + 1 < nk) lstore(cur ^ 1, (kt + 1) * 64);
    if (!NOLOAD && kt + 2 < nk) gload((kt + 2) * 64);
    __builtin_amdgcn_sched_barrier(0);
    const bf16_t* sA = sbuf + cur * STG + (64 * wr + fr) * 72 + 8 * fq;
    const bf16_t* sB = sbuf + cur * STG + 128 * 72 + (64 * wc + fr) * 72 + 8 * fq;
#pragma unroll
    for (int ks = 0; ks < 2; ++ks) {
      bf16x8 a[4], b[4];
#pragma unroll
      for (int i = 0; i < 4; ++i) { a[i] = *(const bf16x8*)(sA + 16 * i * 72 + 32 * ks); b[i] = *(const bf16x8*)(sB + 16 * i * 72 + 32 * ks); }
#pragma unroll
      for (int mi = 0; mi < 4; ++mi)
#pragma unroll
        for (int ni = 0; ni < 4; ++ni) acc[mi][ni] = MFMA16(b[ni], a[mi], acc[mi][ni]);
    }
    __syncthreads();
  }
  epi(acc, m0 + 64 * wr, n0 + 64 * wc, fr, fq);
}

struct EpiInProj {
  bf16_t* U; float* DTRAW;
  DI void operator()(const f32x4 (&acc)[4][4], int mrow, int ncol, int fr, int fq) const {
#pragma unroll
    for (int mi = 0; mi < 4; ++mi) {
      const int row = mrow + 16 * mi + fr;
#pragma unroll
      for (int ni = 0; ni < 4; ++ni) {
        const int col = ncol + 16 * ni + 4 * fq;
        if (col < NIN) {
          u32x2 pk = {pack2(acc[mi][ni][0], acc[mi][ni][1]), pack2(acc[mi][ni][2], acc[mi][ni][3])};
          *(u32x2*)(U + (size_t)row * NIN + col) = pk;
          if (col >= 2304 && col < 2320) *(f32x4*)(DTRAW + row * 16 + col - 2304) = acc[mi][ni];
        }
      }
    }
  }
};
struct EpiResid {
  const float* old_lat; const float* old_ctx; float* new_lat; float* new_ctx; const float* gate_lat; const float* gate_ctx;
  DI void operator()(const f32x4 (&acc)[4][4], int mrow, int ncol, int fr, int fq) const {
#pragma unroll
    for (int mi = 0; mi < 4; ++mi) {
      const int row = mrow + 16 * mi + fr;
      const bool lat = row < L_;
      const float* op = lat ? old_lat + (size_t)row * DM : old_ctx + (size_t)(row - L_) * DM;
      float* np = lat ? new_lat + (size_t)row * DM : new_ctx + (size_t)(row - L_) * DM;
      const float* gp = lat ? gate_lat : gate_ctx;
#pragma unroll
      for (int ni = 0; ni < 4; ++ni) {
        const int col = ncol + 16 * ni + 4 * fq;
        const f32x4 o = *(const f32x4*)(op + col), gt = *(const f32x4*)(gp + col);
        *(f32x4*)(np + col) = o + gt * acc[mi][ni];
      }
    }
  }
};
struct EpiCtxAtomic {
  float* xc; const float* gate;
  DI void operator()(const f32x4 (&acc)[4][4], int mrow, int ncol, int fr, int fq) const {
#pragma unroll
    for (int mi = 0; mi < 4; ++mi) {
      float* np = xc + (size_t)(mrow + 16 * mi + fr - L_) * DM;
#pragma unroll
      for (int ni = 0; ni < 4; ++ni) {
        const int col = ncol + 16 * ni + 4 * fq;
        const f32x4 gt = *(const f32x4*)(gate + col);
#pragma unroll
        for (int j = 0; j < 4; ++j) atomicAdd(np + col + j, gt[j] * acc[mi][ni][j]);
      }
    }
  }
};
struct EpiSwiGLU {
  bf16_t* ACT;
  DI void operator()(const f32x4 (&acc)[4][4], int mrow, int ncol, int fr, int fq) const {
    const int unit0 = (ncol >> 1) + 4 * fq;
#pragma unroll
    for (int mi = 0; mi < 4; ++mi) {
      const int row = mrow + 16 * mi + fr;
#pragma unroll
      for (int ni = 0; ni < 2; ++ni) {
        float o[4];
#pragma unroll
        for (int j = 0; j < 4; ++j) o[j] = siluf(acc[mi][ni][j]) * acc[mi][ni + 2][j];
        u32x2 pk = {pack2(o[0], o[1]), pack2(o[2], o[3])};
        *(u32x2*)(ACT + (size_t)row * FH + unit0 + 16 * ni) = pk;
      }
    }
  }
};

template <bool SCALE_A, bool NOLOAD = false, class Epi>
DI void gemm_tile256(int tix, const float* __restrict__ SSQ, const bf16_t* __restrict__ A, int lda, const bf16_t* __restrict__ Bt, int ldb, int K, int m0, int n0, char* smem, const Epi& epi, int kbeg = 0, int scale_after = -1, bool kperm = false) {
  const int tid = tix, lane = tid & 63, wid = tid >> 6, wr = wid >> 1, wc = wid & 1, fr = lane & 15, fq = lane >> 4;
  bf16_t* sA = (bf16_t*)smem;
  bf16_t* sB = sA + 256 * 72;
  f32x4 acc[8][4];
#pragma unroll
  for (int mi = 0; mi < 8; ++mi)
#pragma unroll
    for (int ni = 0; ni < 4; ++ni) acc[mi][ni] = (f32x4){0.f, 0.f, 0.f, 0.f};
  const int lrow = tid >> 3, lcol = (tid & 7) * 8;
  const bf16_t* ga = A + (size_t)(m0 + lrow) * lda + lcol + kbeg;
  const bf16_t* gb = Bt + (size_t)(n0 + lrow) * ldb + lcol + kbeg;
  u32x4 ra[8], rb[4];
  auto gload = [&](int k0) {
#pragma unroll
    for (int i = 0; i < 8; ++i) ra[i] = *(const u32x4*)(ga + (size_t)(32 * i) * lda + k0);
#pragma unroll
    for (int i = 0; i < 4; ++i) rb[i] = *(const u32x4*)(gb + (size_t)(32 * i) * ldb + k0);
  };
  auto lstore = [&](int k0) {
#pragma unroll
    for (int i = 0; i < 8; ++i) *(u32x4*)(sA + (lrow + 32 * i) * 72 + lcol) = ra[i];
#pragma unroll
    for (int i = 0; i < 4; ++i) *(u32x4*)(sB + (lrow + 32 * i) * 72 + lcol) = rb[i];
  };
  const int nk = K >> 6;
  auto kof = [&](int kt) -> int { return kperm ? (kt < 8 ? 256 + 64 * kt : (kt < 12 ? 64 * (kt - 8) : 768 + 64 * (kt - 12))) : 64 * kt; };
  gload(kof(0));
  for (int kt = 0; kt < nk; ++kt) {
    __syncthreads();
    lstore(kof(kt));
    __syncthreads();
    if (!NOLOAD && kt + 1 < nk) gload(kof(kt + 1));
    const bf16_t* pA = sA + (128 * wr + fr) * 72 + 8 * fq;
    const bf16_t* pB = sB + (64 * wc + fr) * 72 + 8 * fq;
#pragma unroll
    for (int ks = 0; ks < 2; ++ks) {
      bf16x8 b[4];
#pragma unroll
      for (int i = 0; i < 4; ++i) b[i] = *(const bf16x8*)(pB + 16 * i * 72 + 32 * ks);
#pragma unroll
      for (int mh = 0; mh < 4; ++mh) {
        bf16x8 a[2];
#pragma unroll
        for (int i = 0; i < 2; ++i) a[i] = *(const bf16x8*)(pA + 16 * (2 * mh + i) * 72 + 32 * ks);
#pragma unroll
        for (int mi = 0; mi < 2; ++mi)
#pragma unroll
          for (int ni = 0; ni < 4; ++ni) acc[2 * mh + mi][ni] = MFMA16(b[ni], a[mi], acc[2 * mh + mi][ni]);
      }
    }
    if (SCALE_A && kt == scale_after) {
#pragma unroll
      for (int mi = 0; mi < 8; ++mi) {
        const float rs = rsqrtf(SSQ[m0 + 128 * wr + 16 * mi + fr] * (1.f / 512.f) + EPSF);
#pragma unroll
        for (int ni = 0; ni < 4; ++ni) acc[mi][ni] = acc[mi][ni] * rs;
      }
    }
  }
  epi(acc, m0 + 128 * wr, n0 + 64 * wc, fr, fq);
}

struct Epi256InProj {
  bf16_t* U; float* DTRAW;
  DI void operator()(const f32x4 (&acc)[8][4], int mrow, int ncol, int fr, int fq) const {
#pragma unroll
    for (int mi = 0; mi < 8; ++mi) {
      const int row = mrow + 16 * mi + fr;
#pragma unroll
      for (int ni = 0; ni < 4; ++ni) {
        const int col = ncol + 16 * ni + 4 * fq;
        if (col < NIN) {
          u32x2 pk = {pack2(acc[mi][ni][0], acc[mi][ni][1]), pack2(acc[mi][ni][2], acc[mi][ni][3])};
          *(u32x2*)(U + (size_t)row * NIN + col) = pk;
          if (col >= 2304 && col < 2320) *(f32x4*)(DTRAW + row * 16 + col - 2304) = acc[mi][ni];
        }
      }
      __builtin_amdgcn_sched_barrier(0);
    }
  }
};
struct Epi256Resid {
  const float* old_lat; float* new_lat; const float* gate_lat;
  DI void operator()(const f32x4 (&acc)[8][4], int mrow, int ncol, int fr, int fq) const {
#pragma unroll
    for (int mi = 0; mi < 8; ++mi) {
      const int row = mrow + 16 * mi + fr;
      const float* op = old_lat + (size_t)row * DM;
      float* np = new_lat + (size_t)row * DM;
#pragma unroll
      for (int ni = 0; ni < 4; ++ni) {
        const int col = ncol + 16 * ni + 4 * fq;
        const f32x4 o = *(const f32x4*)(op + col), gt = *(const f32x4*)(gate_lat + col);
        *(f32x4*)(np + col) = o + gt * acc[mi][ni];
      }
      __builtin_amdgcn_sched_barrier(0);
    }
  }
};
struct Epi256CtxAtomic {
  float* xc; const float* gate;
  DI void operator()(const f32x4 (&acc)[8][4], int mrow, int ncol, int fr, int fq) const {
#pragma unroll
    for (int mi = 0; mi < 8; ++mi) {
      float* np = xc + (size_t)(mrow + 16 * mi + fr - L_) * DM;
#pragma unroll
      for (int ni = 0; ni < 4; ++ni) {
        const int col = ncol + 16 * ni + 4 * fq;
        const f32x4 gt = *(const f32x4*)(gate + col);
#pragma unroll
        for (int j = 0; j < 4; ++j) atomicAdd(np + col + j, gt[j] * acc[mi][ni][j]);
      }
      __builtin_amdgcn_sched_barrier(0);
    }
  }
};
struct Epi256SwiGLU {
  bf16_t* ACT;
  DI void operator()(const f32x4 (&acc)[8][4], int mrow, int ncol, int fr, int fq) const {
    const int unit0 = (ncol >> 1) + 4 * fq;
#pragma unroll
    for (int mi = 0; mi < 8; ++mi) {
      const int row = mrow + 16 * mi + fr;
#pragma unroll
      for (int ni = 0; ni < 2; ++ni) {
        float o[4];
#pragma unroll
        for (int j = 0; j < 4; ++j) o[j] = siluf(acc[mi][ni][j]) * acc[mi][ni + 2][j];
        u32x2 pk = {pack2(o[0], o[1]), pack2(o[2], o[3])};
        *(u32x2*)(ACT + (size_t)row * FH + unit0 + 16 * ni) = pk;
      }
      __builtin_amdgcn_sched_barrier(0);
    }
  }
};

DI void conv_item(int tix, const Params& p, int layer, int it) {
  const int tb = it >> 2, cgp = it & 3;
  const int lane = tix & 63, tg = tix >> 6;
  const bf16_t* U = (const bf16_t*)(p.ws + OFF_U);
  const int c = cgp * 256 + lane * 4;
  const int row0 = tb * 64 + tg * 16;
  const int seq_lo = (row0 < L_) ? 0 : L_, seq_hi = (row0 < L_) ? L_ : T_;
  f32x4 w[5];
#pragma unroll
  for (int j = 0; j < 5; ++j) w[j] = *(const f32x4*)(p.conv_w + ((size_t)layer * 5 + j) * 1024 + c);
  const f32x4 bias = *(const f32x4*)(p.conv_b + layer * 1024 + c);
  u32x2 xr[20];
#pragma unroll
  for (int i = 0; i < 20; ++i) {
    const int row = row0 + i - 2;
    u32x2 z = {0u, 0u};
    xr[i] = (row >= seq_lo && row < seq_hi) ? *(const u32x2*)(U + (size_t)row * NIN + 1280 + c) : z;
  }
  unsigned o[4][8];
  bf16_t* BC = (bf16_t*)(p.ws + OFF_BC);
#pragma unroll
  for (int i = 0; i < 16; i += 2) {
    float y0[4], y1[4];
#pragma unroll
    for (int q = 0; q < 4; ++q) { y0[q] = bias[q]; y1[q] = bias[q]; }
#pragma unroll
    for (int j = 0; j < 5; ++j) {
      const u32x2 a = xr[i + j], b = xr[i + 1 + j];
      y0[0] += w[j][0] * bflo(a[0]); y0[1] += w[j][1] * bfhi(a[0]); y0[2] += w[j][2] * bflo(a[1]); y0[3] += w[j][3] * bfhi(a[1]);
      y1[0] += w[j][0] * bflo(b[0]); y1[1] += w[j][1] * bfhi(b[0]); y1[2] += w[j][2] * bflo(b[1]); y1[3] += w[j][3] * bfhi(b[1]);
    }
#pragma unroll
    for (int q = 0; q < 4; ++q) { y0[q] = siluf(y0[q]); y1[q] = siluf(y1[q]); o[q][i >> 1] = pack2(y0[q], y1[q]); }
    if (cgp >= 2) {
      u32x2 t0 = {pack2(y0[0], y0[1]), pack2(y0[2], y0[3])}, t1 = {pack2(y1[0], y1[1]), pack2(y1[2], y1[3])};
      *(u32x2*)(BC + (size_t)(row0 + i) * 512 + (c - 512)) = t0;
      *(u32x2*)(BC + (size_t)(row0 + i + 1) * 512 + (c - 512)) = t1;
    }
  }
  if (cgp < 3) {
    bf16_t* XBT = (bf16_t*)(p.ws + OFF_XBT);
    const int gc = row0 >> 7, tl = row0 & 127;
#pragma unroll
    for (int q = 0; q < 4; ++q) {
      u32x4 lo = {o[q][0], o[q][1], o[q][2], o[q][3]}, hi = {o[q][4], o[q][5], o[q][6], o[q][7]};
      u32x4* d = (u32x4*)(XBT + ((size_t)gc * 768 + c + q) * 128 + tl);
      d[0] = lo; d[1] = hi;
    }
  }
}

DI void dt_item(int tix, const Params& p, int layer, int gc, char* smem) {
  const int tid = tix, lane = tid & 63, wid = tid >> 6;
  const float* DTRAW = (const float*)(p.ws + OFF_DTRAW);
  float* DT = (float*)(p.ws + OFF_DT);
  float* AC = (float*)(p.ws + OFF_ACUM);
  if (tid < 128) ((float*)(p.ws + OFF_SSQ))[gc * 128 + tid] = 0.f;
#pragma unroll
  for (int ci = 0; ci < 4; ++ci) {
    const int col = wid * 4 + ci;
    const int d = col >> 3;
    const float bias = p.dt_bias[layer * 16 + col];
    const float a = -__expf(p.a_log[layer * 16 + col]);
    const int i0 = 2 * lane, i1 = 2 * lane + 1;
    const int t0 = d ? 127 - i0 : i0, t1 = d ? 127 - i1 : i1;
    const size_t r0 = (size_t)(gc * 128 + t0) * 16 + col, r1 = (size_t)(gc * 128 + t1) * 16 + col;
    float x0 = DTRAW[r0] + bias, x1 = DTRAW[r1] + bias;
    const float dt0 = x0 > 20.f ? x0 : log1pf(__expf(x0));
    const float dt1 = x1 > 20.f ? x1 : log1pf(__expf(x1));
    const float v0 = dt0 * a, v1 = dt1 * a;
    float s = v0 + v1, inc = s;
    for (int o = 1; o < 64; o <<= 1) { const float n = __int_as_float(__builtin_amdgcn_ds_bpermute((lane - o) << 2, __float_as_int(inc))); if (lane >= o) inc += n; }
    const float excl = inc - s;
    DT[r0] = dt0; DT[r1] = dt1;
    AC[r0] = excl + v0; AC[r1] = excl + v0 + v1;
  }
}

DI void qk_item(int tix, const Params& p, int layer, int it) {
  const int rid2 = it * NT + tix;
  const int half = rid2 & 1, rowid = rid2 >> 1;
  const int tok = rowid / 6, hsel = rowid - tok * 6;
  const bf16_t* U = (const bf16_t*)(p.ws + OFF_U);
  const f32x2* R = (const f32x2*)(p.ws + OFF_ROPE);
  const u32x4* src = (const u32x4*)(U + (size_t)tok * NIN + 2320 + hsel * 64 + 32 * half);
  float x[32];
  float ss = 0.f;
#pragma unroll
  for (int i = 0; i < 4; ++i) {
    const u32x4 v = src[i];
#pragma unroll
    for (int q = 0; q < 4; ++q) { x[8 * i + 2 * q] = bflo(v[q]); x[8 * i + 2 * q + 1] = bfhi(v[q]); }
  }
#pragma unroll
  for (int i = 0; i < 32; ++i) ss += x[i] * x[i];
  ss += shx(ss, 1, tix & 63);
  const float rstd = rsqrtf(ss * (1.f / 64.f) + EPSF);
  const f32x4* nw = (const f32x4*)((hsel < 4 ? p.q_norm_w : p.k_norm_w) + layer * 64 + 32 * half);
#pragma unroll
  for (int i = 0; i < 8; ++i) {
    const f32x4 w = nw[i];
#pragma unroll
    for (int j = 0; j < 4; ++j) x[4 * i + j] = x[4 * i + j] * rstd * w[j];
  }
  if (tok < L_) {
    const int pos = half ? (tok & 63) : (tok >> 6);
#pragma unroll
    for (int j = 0; j < 16; ++j) {
      const f32x2 cs = R[pos * 16 + j];
      const float a = x[j], b = x[16 + j];
      x[j] = a * cs[0] - b * cs[1];
      x[16 + j] = b * cs[0] + a * cs[1];
    }
  }
  const float sc = hsel < 4 ? 0.125f * LOG2E : 1.f;
  u32x4* dst = (hsel < 4) ? (u32x4*)((bf16_t*)(p.ws + OFF_QG) + (size_t)tok * 256 + hsel * 64 + 32 * half)
                          : (u32x4*)((bf16_t*)(p.ws + OFF_KG) + (size_t)tok * 128 + (hsel - 4) * 64 + 32 * half);
#pragma unroll
  for (int i = 0; i < 4; ++i) {
    u32x4 o;
#pragma unroll
    for (int q = 0; q < 4; ++q) o[q] = pack2(x[8 * i + 2 * q] * sc, x[8 * i + 2 * q + 1] * sc);
    dst[i] = o;
  }
}

DI void vtr_item(int tix, const Params& p, int it) {
  const bf16_t* U = (const bf16_t*)(p.ws + OFF_U);
  int row0, c, col0; bf16_t* dst;
  if (it < 260) { row0 = it * 64 + (tix >> 6) * 16; c = (tix & 63) * 4; col0 = 512; dst = (bf16_t*)(p.ws + OFF_VNT); }
  else { row0 = (it - 260) * 128 + (tix >> 5) * 16; c = (tix & 31) * 4; col0 = 2320 + 384; dst = (bf16_t*)(p.ws + OFF_VGT); }
  u32x2 xr[16];
#pragma unroll
  for (int i = 0; i < 16; ++i) xr[i] = *(const u32x2*)(U + (size_t)(row0 + i) * NIN + col0 + c);
#pragma unroll
  for (int q = 0; q < 4; ++q) {
    unsigned o[8];
#pragma unroll
    for (int i = 0; i < 8; ++i) {
      const unsigned a = xr[2 * i][q >> 1], b = xr[2 * i + 1][q >> 1];
      o[i] = (q & 1) ? ((a >> 16) | (b & 0xffff0000u)) : ((a & 0xffffu) | (b << 16));
    }
    u32x4 lo = {o[0], o[1], o[2], o[3]}, hi = {o[4], o[5], o[6], o[7]};
    u32x4* d = (u32x4*)(dst + (size_t)(c + q) * T_ + row0);
    d[0] = lo; d[1] = hi;
  }
}

struct AttnState { f32x16 o[2]; float m, l; };

template <class KF, class VF, class SF>
DI void attn_tile(AttnState& st, int lane, bool first, float cinv, const bf16x8 (&qf)[4], const KF& kf, const VF& vf, const SF& sf) {
  f32x16 s[2];
  const float init = first ? 0.f : -st.m * cinv;
#pragma unroll
  for (int ks = 0; ks < 2; ++ks) {
#pragma unroll
    for (int i = 0; i < 16; ++i) s[ks][i] = init;
#pragma unroll
    for (int kk = 0; kk < 4; ++kk) s[ks] = MFMA32(kf(ks, kk), qf[kk], s[ks]);
  }
  sf(s);
  if (first) {
    float mx = fmaxf(s[0][0], s[1][0]);
#pragma unroll
    for (int i = 1; i < 16; ++i) mx = fmaxf(mx, fmaxf(s[0][i], s[1][i]));
    mx = fmaxf(mx, shx(mx, 32, lane));
    if (mx == -INFINITY) mx = 0.f;
    st.m = mx;
#pragma unroll
    for (int i = 0; i < 16; ++i) { s[0][i] -= mx; s[1][i] -= mx; }
  }
  float sum = 0.f;
#pragma unroll
  for (int ks = 0; ks < 2; ++ks)
#pragma unroll
    for (int i = 0; i < 16; ++i) { const float pv = __builtin_amdgcn_exp2f(s[ks][i]); s[ks][i] = pv; sum += pv; }
  sum += shx(sum, 32, lane);
  if (__any(sum > 65536.f)) {
    const float delta = sum > 65536.f ? ceilf(__log2f(sum)) : 0.f;
    const float sc = __builtin_amdgcn_exp2f(-delta);
    st.m += delta; st.l *= sc; sum *= sc;
#pragma unroll
    for (int i = 0; i < 16; ++i) { s[0][i] *= sc; s[1][i] *= sc; st.o[0][i] *= sc; st.o[1][i] *= sc; }
  }
  st.l += sum;
#pragma unroll
  for (int ks = 0; ks < 2; ++ks) {
    const bf16x8 p0 = pack8<0>(s[ks]), p1 = pack8<1>(s[ks]);
#pragma unroll
    for (int dt = 0; dt < 2; ++dt) {
      st.o[dt] = MFMA32(vf(dt, ks, 0), p0, st.o[dt]);
      st.o[dt] = MFMA32(vf(dt, ks, 1), p1, st.o[dt]);
    }
  }
}
DI void attn_store(const AttnState& st, bf16_t* __restrict__ dst  , int hh) {
  const float inv = 1.f / st.l;
#pragma unroll
  for (int dt = 0; dt < 2; ++dt)
#pragma unroll
    for (int g = 0; g < 4; ++g) {
      u32x2 pk = {pack2(st.o[dt][4 * g] * inv, st.o[dt][4 * g + 1] * inv), pack2(st.o[dt][4 * g + 2] * inv, st.o[dt][4 * g + 3] * inv)};
      *(u32x2*)(dst + 32 * dt + 8 * g + 4 * hh) = pk;
    }
}

DI void gqa_item(int tix, const Params& p, int qrow0, int g, int kt0, int kt1, char* smem) {
  const int tid = tix, lane = tid & 63, wid = tid >> 6, r = lane & 31, hh = lane >> 5;
  const int head = 2 * g + (wid >> 1), qsub = wid & 1;
  const bf16_t* QG = (const bf16_t*)(p.ws + OFF_QG);
  const bf16_t* KG = (const bf16_t*)(p.ws + OFF_KG);
  const bf16_t* VGT = (const bf16_t*)(p.ws + OFF_VGT);
  bf16_t* Y = (bf16_t*)(p.ws + OFF_A1);
  bf16_t* sbuf = (bf16_t*)smem;
  constexpr int STG = 64 * 72 + 64 * 68;
  const int qrow = qrow0 + 32 * qsub + r;
  bf16x8 qf[4];
#pragma unroll
  for (int kk = 0; kk < 4; ++kk) qf[kk] = *(const bf16x8*)(QG + (size_t)qrow * 256 + head * 64 + 16 * kk + 8 * hh);
  AttnState st; st.o[0] = zero16(); st.o[1] = zero16(); st.m = 0.f; st.l = 0.f;
  const int lrow = tid >> 3, lcol = (tid & 7) * 8;
  const bf16_t* gk = KG + (size_t)lrow * 128 + g * 64 + lcol;
  const bf16_t* gv = VGT + (size_t)(g * 64 + lrow) * T_ + lcol;
  u32x4 rk0[2], rv0[2], rk1[2], rv1[2];
  auto gload = [&](int kt, u32x4 (&rk)[2], u32x4 (&rv)[2]) {
    if (kt < kt1) {
      const size_t key0 = (size_t)kt * 64;
      rk[0] = *(const u32x4*)(gk + key0 * 128); rk[1] = *(const u32x4*)(gk + (key0 + 32) * 128);
      rv[0] = *(const u32x4*)(gv + key0); rv[1] = *(const u32x4*)(gv + (size_t)32 * T_ + key0);
    }
  };
  auto lstore = [&](int stage, const u32x4 (&rk)[2], const u32x4 (&rv)[2]) {
    bf16_t* sK = sbuf + stage * STG; bf16_t* sV = sK + 64 * 72;
    *(u32x4*)(sK + lrow * 72 + lcol) = rk[0]; *(u32x4*)(sK + (lrow + 32) * 72 + lcol) = rk[1];
    u32x2 a = {rv[0][0], rv[0][1]}, b = {rv[0][2], rv[0][3]}, c = {rv[1][0], rv[1][1]}, d = {rv[1][2], rv[1][3]};
    *(u32x2*)(sV + lrow * 68 + lcol) = a; *(u32x2*)(sV + lrow * 68 + lcol + 4) = b;
    *(u32x2*)(sV + (lrow + 32) * 68 + lcol) = c; *(u32x2*)(sV + (lrow + 32) * 68 + lcol + 4) = d;
  };
  auto compute = [&](int stage, bool first) {
    const bf16_t* sK = sbuf + stage * STG; const bf16_t* sV = sK + 64 * 72;
    auto kf = [&](int ks, int kk) -> bf16x8 { return *(const bf16x8*)(sK + (32 * ks + r) * 72 + 16 * kk + 8 * hh); };
    auto vf = [&](int dt, int ks, int step) -> bf16x8 {
      const bf16_t* b = sV + (32 * dt + r) * 68 + 32 * ks + 16 * step + 4 * hh;
      return cat44(*(const u32x2*)b, *(const u32x2*)(b + 8));
    };
    auto sf = [&](f32x16 (&sx)[2]) {};
    attn_tile(st, lane, first, 1.f, qf, kf, vf, sf);
  };
  gload(kt0, rk0, rv0); gload(kt0 + 1, rk1, rv1);
  __syncthreads();
  lstore(0, rk0, rv0);
  gload(kt0 + 2, rk0, rv0);
  __syncthreads();
  for (int kt = kt0; kt < kt1; kt += 2) {
    lstore(1, rk1, rv1);
    gload(kt + 3, rk1, rv1);
    __builtin_amdgcn_sched_barrier(0);
    compute(0, kt == kt0);
    __syncthreads();
    if (kt + 2 < kt1) lstore(0, rk0, rv0);
    gload(kt + 4, rk0, rv0);
    __builtin_amdgcn_sched_barrier(0);
    compute(1, false);
    __syncthreads();
  }
  attn_store(st, Y + (size_t)qrow * DM + 768 + head * 64, hh);
}

DI void na_item(int tix, const Params& p, int layer, int rowidx, int hp, bool is_ctx, char* smem) {
  const int tid = tix, lane = tid & 63, wid = tid >> 6, r = lane & 31, hh = lane >> 5;
  const int head = 2 * hp + (wid >> 1), qsub = wid & 1;
  const bf16_t* U = (const bf16_t*)(p.ws + OFF_U);
  const bf16_t* VNT = (const bf16_t*)(p.ws + OFF_VNT);
  bf16_t* Y = (bf16_t*)(p.ws + OFF_A1);
  float* srpb = (float*)smem;
  __syncthreads();
  for (int i = tid; i < 2 * 465; i += NT) srpb[i] = p.na_rpb[((size_t)layer * 4 + 2 * hp) * 465 + i] * LOG2E;
  __syncthreads();
  const float* myrpb = srpb + (wid >> 1) * 465;
  const int qc = 32 * qsub + r;
  const int qrow = (is_ctx ? L_ + rowidx * 64 : rowidx * 64) + qc;
  bf16x8 qf[4];
#pragma unroll
  for (int kk = 0; kk < 4; ++kk) qf[kk] = *(const bf16x8*)(U + (size_t)qrow * NIN + head * 64 + 16 * kk + 8 * hh);
  AttnState st; st.o[0] = zero16(); st.o[1] = zero16(); st.m = 0.f; st.l = 0.f;
  const float c1 = 0.125f * LOG2E;
  const int r_start = min(max(rowidx - 4, 0), 248);
  const int cs = min(max(qc - 8, 0), 48);
  const int ntile = is_ctx ? 4 : 12;
  auto tok_of = [&](int t) -> int { const bool w = (!is_ctx) && (t < 8); return w ? (r_start + t) * 64 : L_ + (is_ctx ? t : t - 8) * 64; };
  bf16x8 kreg[8], kregn[8];
  auto ldK = [&](int t, bf16x8 (&kr)[8]) {
    const bf16_t* kb = U + (size_t)tok_of(t) * NIN + 256 + head * 64 + 8 * hh;
#pragma unroll
    for (int ks = 0; ks < 2; ++ks)
#pragma unroll
      for (int kk = 0; kk < 4; ++kk) kr[ks * 4 + kk] = *(const bf16x8*)(kb + (size_t)(32 * ks + r) * NIN + 16 * kk);
  };
  ldK(0, kreg);
#pragma unroll 1
  for (int t = 0; t < ntile; ++t) {
    const bool win = (!is_ctx) && (t < 8);
    const int tok0 = tok_of(t);
    const bf16_t* vb = VNT + (size_t)(head * 64) * T_ + tok0 + 4 * hh;
    u32x2 vreg[32];
#pragma unroll
    for (int dt = 0; dt < 2; ++dt)
#pragma unroll
      for (int ks = 0; ks < 2; ++ks)
#pragma unroll
        for (int step = 0; step < 2; ++step) {
          const bf16_t* b = vb + (size_t)(32 * dt + r) * T_ + 32 * ks + 16 * step;
          vreg[((dt * 2 + ks) * 2 + step) * 2] = *(const u32x2*)b; vreg[((dt * 2 + ks) * 2 + step) * 2 + 1] = *(const u32x2*)(b + 8);
        }
    if (t + 1 < ntile) ldK(t + 1, kregn);
    __builtin_amdgcn_sched_barrier(0);
    auto kf = [&](int ks, int kk) -> bf16x8 { return kreg[ks * 4 + kk]; };
    auto vf = [&](int dt, int ks, int step) -> bf16x8 { return cat44(vreg[((dt * 2 + ks) * 2 + step) * 2], vreg[((dt * 2 + ks) * 2 + step) * 2 + 1]); };
    const float* rp = myrpb + (r_start + t - rowidx + 7) * 31 + 15 - qc;
    auto sf = [&](f32x16 (&s)[2]) {
#pragma unroll
      for (int ks = 0; ks < 2; ++ks)
#pragma unroll
        for (int i = 0; i < 16; ++i) {
          const int kc = 32 * ks + crow(i, hh);
          if (win) {
            const bool ok = (kc >= cs) && (kc < cs + 16);
            s[ks][i] = ok ? (s[ks][i] * c1 + rp[ok ? kc : qc]) : -INFINITY;
          } else s[ks][i] = s[ks][i] * c1;
        }
    };
    attn_tile(st, lane, t == 0, 1.f / c1, qf, kf, vf, sf);
    if (t + 1 < ntile) {
#pragma unroll
      for (int j = 0; j < 8; ++j) kreg[j] = kregn[j];
    }
  }
  attn_store(st, Y + (size_t)qrow * DM + head * 64, hh);
}

DI void ssd_s1_item(int tix, const Params& p, int gc, int h, char* smem) {
  const int tid = tix, lane = tid & 63, wid = tid >> 6, r = lane & 31, hh = lane >> 5;
  const float* DT = (const float*)(p.ws + OFF_DT);
  const float* AC = (const float*)(p.ws + OFF_ACUM);
  float* CDEC = (float*)(p.ws + OFF_CDEC);
  const bf16_t* XBT = (const bf16_t*)(p.ws + OFF_XBT) + (size_t)gc * 768 * 128;
  bf16_t* ST = (bf16_t*)(p.ws + OFF_ST);
  float* sw = (float*)smem;
  __syncthreads();
  {
    const int d = tid >> 7, t = tid & 127, col = d * 8 + h;
    const float tot = AC[(size_t)(gc * 128 + (d ? 0 : 127)) * 16 + col];
    const float ac = AC[(size_t)(gc * 128 + t) * 16 + col], dt = DT[(size_t)(gc * 128 + t) * 16 + col];
    sw[d * 128 + t] = __expf(tot - ac) * dt;
    if (t == 0) CDEC[(d * 8 + h) * NCH + gc] = __expf(tot);
  }
  __syncthreads();
  const int g = h >> 2;
  f32x16 acc[2][2];
  acc[0][0] = zero16(); acc[0][1] = zero16(); acc[1][0] = zero16(); acc[1][1] = zero16();
#pragma unroll
  for (int kk = 0; kk < 8; ++kk) {
    const int kb = 16 * kk + 8 * hh;
    const bf16x8 bfrag = *(const bf16x8*)(XBT + (size_t)(512 + g * 128 + 32 * wid + r) * 128 + kb);
    float wf[8], wb[8];
#pragma unroll
    for (int j = 0; j < 8; ++j) { wf[j] = sw[kb + j]; wb[j] = sw[128 + kb + j]; }
#pragma unroll
    for (int mt = 0; mt < 2; ++mt) {
      const u32x4 xr = *(const u32x4*)(XBT + (size_t)(h * 64 + 32 * mt + r) * 128 + kb);
      u32x4 af, ab;
#pragma unroll
      for (int q = 0; q < 4; ++q) {
        const float lo = bflo(xr[q]), hi = bfhi(xr[q]);
        af[q] = pack2(lo * wf[2 * q], hi * wf[2 * q + 1]);
        ab[q] = pack2(lo * wb[2 * q], hi * wb[2 * q + 1]);
      }
      acc[0][mt] = MFMA32(bfrag, __builtin_bit_cast(bf16x8, af), acc[0][mt]);
      acc[1][mt] = MFMA32(bfrag, __builtin_bit_cast(bf16x8, ab), acc[1][mt]);
    }
  }
#pragma unroll
  for (int d = 0; d < 2; ++d)
#pragma unroll
    for (int mt = 0; mt < 2; ++mt)
#pragma unroll
      for (int q4 = 0; q4 < 4; ++q4) {
        const int pp = 32 * mt + r, n = 32 * wid + 8 * q4 + 4 * hh;
        u32x2 pk = {pack2(acc[d][mt][4 * q4], acc[d][mt][4 * q4 + 1]), pack2(acc[d][mt][4 * q4 + 2], acc[d][mt][4 * q4 + 3])};
        *(u32x2*)(ST + ((size_t)(d * 8 + h) * NCH + gc) * 8192 + pp * 128 + n) = pk;
      }
}

DI void ssd_scan_item(int tix, const Params& p, int it) {
  const int e2 = it * NT + tix;
  const int dh = e2 >> 12, within = e2 & 4095, d = dh >> 3;
  unsigned* ST = (unsigned*)(p.ws + OFF_ST) + (size_t)dh * NCH * 4096 + within;
  const float* CDEC = (const float*)(p.ws + OFF_CDEC) + dh * NCH;
  float r0 = 0.f, r1 = 0.f;
  for (int b = 0; b < 5; ++b) {
    unsigned v[26]; float dec[26];
#pragma unroll
    for (int j = 0; j < 26; ++j) {
      const int i = b * 26 + j;
      const int gc = d ? (129 - i) : (i < 2 ? 128 + i : i - 2);
      v[j] = ST[(size_t)gc * 4096]; dec[j] = CDEC[gc];
    }
#pragma unroll
    for (int j = 0; j < 26; ++j) {
      const int i = b * 26 + j;
      const int gc = d ? (129 - i) : (i < 2 ? 128 + i : i - 2);
      ST[(size_t)gc * 4096] = pack2(r0, r1);
      r0 = dec[j] * r0 + bflo(v[j]); r1 = dec[j] * r1 + bfhi(v[j]);
    }
  }
}

DI void ssd_s3_item(int tix, const Params& p, int layer, int gc, int tq, int g, char* smem, bool do_atomic) {
  const int tid = tix, lane = tid & 63, wid = tid >> 6, r = lane & 31, hh = lane >> 5;
  const float* DT = (const float*)(p.ws + OFF_DT);
  const float* AC = (const float*)(p.ws + OFF_ACUM);
  const bf16_t* XBT = (const bf16_t*)(p.ws + OFF_XBT) + (size_t)gc * 768 * 128;
  const bf16_t* BC = (const bf16_t*)(p.ws + OFF_BC) + (size_t)gc * 128 * 512;
  const bf16_t* ST = (const bf16_t*)(p.ws + OFF_ST);
  const bf16_t* U = (const bf16_t*)(p.ws + OFF_U);
  bf16_t* Y = (bf16_t*)(p.ws + OFF_A1);
  float* SSQ = (float*)(p.ws + OFF_SSQ);
  float* sAc = (float*)smem;
  float* sDt = sAc + 16 * 128;
  const int h = 4 * g + wid;
  const int tl = 32 * tq + r;
  const size_t trow = (size_t)gc * 128 + tl;
  f32x4 fa[2], fd[2];
#pragma unroll
  for (int i = 0; i < 2; ++i) { fa[i] = *(const f32x4*)(AC + (size_t)(gc * 128) * 16 + 4 * (tid + NT * i)); fd[i] = *(const f32x4*)(DT + (size_t)(gc * 128) * 16 + 4 * (tid + NT * i)); }
  bf16x8 cf[8];
#pragma unroll
  for (int kk = 0; kk < 8; ++kk) cf[kk] = *(const bf16x8*)(BC + (size_t)tl * 512 + 256 + g * 128 + 16 * kk + 8 * hh);
  bf16x8 bfc[8], bfn[8]; u32x2 xac[8], xan[8];
  auto ldB = [&](int stl, bf16x8 (&bf)[8], u32x2 (&xa)[8]) {
#pragma unroll
    for (int kk = 0; kk < 8; ++kk) bf[kk] = *(const bf16x8*)(BC + (size_t)(32 * stl + r) * 512 + g * 128 + 16 * kk + 8 * hh);
    const bf16_t* xb0 = XBT + (size_t)(h * 64 + r) * 128 + 32 * stl + 4 * hh;
#pragma unroll
    for (int q = 0; q < 4; ++q) { xa[q] = *(const u32x2*)(xb0 + 8 * q); xa[4 + q] = *(const u32x2*)(xb0 + 32 * 128 + 8 * q); }
  };
  ldB(0, bfc, xac);
  __syncthreads();
#pragma unroll
  for (int i = 0; i < 2; ++i) { *(f32x4*)(sAc + 4 * (tid + NT * i)) = fa[i]; *(f32x4*)(sDt + 4 * (tid + NT * i)) = fd[i]; }
  __syncthreads();
  const float acf_t = sAc[tl * 16 + h], acb_t = sAc[tl * 16 + 8 + h];
  const float Dh = p.ssd_d[layer * 8 + h];
  f32x16 y[2]; y[0] = zero16(); y[1] = zero16();
  u32x2 zz[8];
#pragma unroll
  for (int stl = 0; stl < 4; ++stl) {
    if (stl < 3) ldB(stl + 1, bfn, xan);
    else {
#pragma unroll
      for (int q = 0; q < 8; ++q) zz[q] = *(const u32x2*)(U + trow * NIN + 768 + h * 64 + 32 * (q >> 2) + 8 * (q & 3) + 4 * hh);
    }
    __builtin_amdgcn_sched_barrier(0);
    f32x16 gt = zero16();
#pragma unroll
    for (int kk = 0; kk < 8; ++kk) gt = MFMA32(bfc[kk], cf[kk], gt);
    f32x16 pt;
#pragma unroll
    for (int reg = 0; reg < 16; ++reg) {
      const int s = 32 * stl + crow(reg, hh);
      float f = 0.f;
      if (s <= tl) f += __expf(acf_t - sAc[s * 16 + h]) * sDt[s * 16 + h];
      if (s >= tl) f += __expf(acb_t - sAc[s * 16 + 8 + h]) * sDt[s * 16 + 8 + h];
      pt[reg] = gt[reg] * f + (s == tl ? Dh : 0.f);
    }
    const bf16x8 p0 = pack8<0>(pt), p1 = pack8<1>(pt);
    y[0] = MFMA32(cat44(xac[0], xac[1]), p0, y[0]); y[0] = MFMA32(cat44(xac[2], xac[3]), p1, y[0]);
    y[1] = MFMA32(cat44(xac[4], xac[5]), p0, y[1]); y[1] = MFMA32(cat44(xac[6], xac[7]), p1, y[1]);
    if (stl < 3) {
#pragma unroll
      for (int kk = 0; kk < 8; ++kk) bfc[kk] = bfn[kk];
#pragma unroll
      for (int q = 0; q < 8; ++q) xac[q] = xan[q];
    }
  }
#pragma unroll
  for (int d = 0; d < 2; ++d) {
    const bf16_t* Hb = ST + ((size_t)(d * 8 + h) * NCH + gc) * 8192;
    bf16x8 hf[2][8];
#pragma unroll
    for (int mt = 0; mt < 2; ++mt)
#pragma unroll
      for (int kk = 0; kk < 8; ++kk) hf[mt][kk] = *(const bf16x8*)(Hb + (size_t)(32 * mt + r) * 128 + 16 * kk + 8 * hh);
    f32x16 a2[2]; a2[0] = zero16(); a2[1] = zero16();
#pragma unroll
    for (int kk = 0; kk < 8; ++kk) { a2[0] = MFMA32(hf[0][kk], cf[kk], a2[0]); a2[1] = MFMA32(hf[1][kk], cf[kk], a2[1]); }
    const float e = __expf(d ? acb_t : acf_t);
#pragma unroll
    for (int mt = 0; mt < 2; ++mt)
#pragma unroll
      for (int reg = 0; reg < 16; ++reg) y[mt][reg] += e * a2[mt][reg];
  }
  float ssq = 0.f;
#pragma unroll
  for (int mt = 0; mt < 2; ++mt)
#pragma unroll
    for (int q4 = 0; q4 < 4; ++q4) {
      const int p0 = 32 * mt + 8 * q4 + 4 * hh;
      const u32x2 z2 = zz[4 * mt + q4];
      const f32x4 nw = *(const f32x4*)(p.ssd_norm_w + layer * 512 + h * 64 + p0);
      float zv[4] = {bflo(z2[0]), bfhi(z2[0]), bflo(z2[1]), bfhi(z2[1])};
      float o[4];
#pragma unroll
      for (int j = 0; j < 4; ++j) {
        const float yy = y[mt][4 * q4 + j] * siluf(zv[j]);
        ssq += yy * yy;
        o[j] = yy * nw[j];
      }
      u32x2 pk = {pack2(o[0], o[1]), pack2(o[2], o[3])};
      *(u32x2*)(Y + trow * DM + 256 + h * 64 + p0) = pk;
    }
  ssq += shx(ssq, 32, lane);
  if (hh == 0 && do_atomic) atomicAdd(SSQ + trow, ssq);
}

enum { PH_INIT = 0, PH_NORM1, PH_INPROJ, PH_PREP, PH_MIX1, PH_SCAN, PH_S3, PH_OUTPROJ, PH_NORM2, PH_FFN1, PH_FFN2, PH_FINAL };

DI void run_phase(const Params& p, int ph, int layer, int bid, int nb, char* smem, bool last_rep = true) {
  int tix = threadIdx.x;
  asm volatile("" : "+v"(tix));
  const bool ctx_out = layer < 1;
  const float* MOD = (const float*)(p.ws + OFF_MOD);
  switch (ph) {
    case PH_INIT: {
      const int total = 192 + 16 + 64 + WC_TOTAL;
      for (int it = bid; it < total; it += nb) {
        int tx = tix; asm volatile("" : "+v"(tx));
        if (it < 192) mod_item(tx, p, it, smem);
        else if (it < 208) rope_item(tx, p, it - 192);
        else if (it < 272) {
          const f32x4* src = (const f32x4*)(p.ctx + (size_t)(it - 208) * 4096); f32x4* dst = (f32x4*)((float*)(p.ws + OFF_XC) + (size_t)(it - 208) * 4096);
#pragma unroll
          for (int i = 0; i < 4; ++i) dst[tx + NT * i] = src[tx + NT * i];
        }
        else wconv_item(tx, p, 0, it - 272, smem);
      }
    } break;
    case PH_NORM1: {
      norm_rows(tix, p, layer, 0, bid, nb, T_ / 8);
      if (layer > 0) {
        const int total = T_ / 8 + WC_TOTAL;
        int first = bid + ((T_ / 8 - bid + nb - 1) / nb) * nb;
        for (int it = first; it < total; it += nb) {
          int tx = tix; asm volatile("" : "+v"(tx));
          wconv_item(tx, p, layer, it - T_ / 8, smem);
        }
      }
    } break;
    case PH_INPROJ: {
      Epi256InProj epi{(bf16_t*)(p.ws + OFF_U), (float*)(p.ws + OFF_DTRAW)};
      const int total = 65 * 23;
      for (int it = bid; it < total; it += nb) {
        int tx = tix; asm volatile("" : "+v"(tx));
#ifdef PROBE_NOLOAD
        if (!last_rep) gemm_tile256<false, true>(tx, nullptr, (const bf16_t*)(p.ws + OFF_A1), DM, (const bf16_t*)(p.ws + OFF_WIN), DM, DM, (it / 23) * 256, (it % 23) * 128, smem, epi); else
#endif
        gemm_tile256<false>(tx, nullptr, (const bf16_t*)(p.ws + OFF_A1), DM, (const bf16_t*)(p.ws + OFF_WIN), DM, DM, (it / 23) * 256, (it % 23) * 128, smem, epi);
      }
    } break;
    case PH_PREP: {
      const int n0 = 260 * 4, n1 = n0 + NCH, n2 = n1 + 780, n3 = n2 + 260 + 130;
      for (int it = bid; it < n3; it += nb) {
        int tx = tix; asm volatile("" : "+v"(tx));
        if (it < n0) conv_item(tx, p, layer, it);
        else if (it < n1) dt_item(tx, p, layer, it - n0, smem);
        else if (it < n2) qk_item(tx, p, layer, it - n1);
        else vtr_item(tx, p, it - n2);
      }
    } break;
    case PH_MIX1: {
      const int nctx = ctx_out ? 8 : 0;
      const int n0 = 512, n1 = n0 + nctx, n2 = n1 + 512, n3 = n2 + nctx, n4 = n3 + NCH * 8;
      const int nround = (n4 + nb - 1) / nb;
      for (int kk = 0; kk < nround; ++kk) {
        const int k = (bid >= (nb >> 1)) ? ((kk + 1 == nround) ? 0 : kk + 1) : kk;
        const int it = bid + k * nb;
        if (it >= n4) continue;
        int tx = tix; asm volatile("" : "+v"(tx));
        if (it < n0) gqa_item(tx, p, ((it & 3) + 4 * (it >> 3)) * 64, (it >> 2) & 1, 0, 260, smem);
        else if (it < n1) { const int j = it - n0; gqa_item(tx, p, L_ + (j >> 1) * 64, j & 1, 256, 260, smem); }
        else if (it < n2) { const int j = it - n1; na_item(tx, p, layer, j >> 1, j & 1, false, smem); }
        else if (it < n3) { const int j = it - n2; na_item(tx, p, layer, j >> 1, j & 1, true, smem); }
        else { const int j = it - n3; ssd_s1_item(tx, p, j >> 3, j & 7, smem); }
      }
    } break;
    case PH_SCAN: {
      for (int it = bid; it < 256; it += nb) ssd_scan_item(tix, p, it);
    } break;
    case PH_S3: {
      const int total = (ctx_out ? NCH : 128) * 8;
      for (int it = bid; it < total; it += nb) {
        int tx = tix; asm volatile("" : "+v"(tx));
        ssd_s3_item(tx, p, layer, it >> 3, (it >> 1) & 3, it & 1, smem, last_rep);
      }
    } break;
    case PH_OUTPROJ: {
      EpiResid epi{layer == 0 ? p.x : p.out, (const float*)(p.ws + OFF_XC), p.out, (float*)(p.ws + OFF_XC),
                   MOD + (layer * 2 + 0) * 6144 + 2 * DM, MOD + (layer * 2 + 1) * 6144 + 2 * DM};
      EpiCtxAtomic epc{(float*)(p.ws + OFF_XC), MOD + (layer * 2 + 1) * 6144 + 2 * DM};
      const int nsplit = ctx_out ? 64 : 0;
      const int total = nsplit + 128 * 8;
      for (int it = bid; it < total; it += nb) {
        int tx = tix; asm volatile("" : "+v"(tx));
        if (it < nsplit) { const int tile = it >> 2, kq = it & 3;
          gemm_tile<true>(tx, (const float*)(p.ws + OFF_SSQ), (const bf16_t*)(p.ws + OFF_A1), DM, (const bf16_t*)(p.ws + OFF_WOUT), DM, DM / 4, L_ + (tile >> 3) * 128, (tile & 7) * 128, smem, epc, kq * (DM / 4));
        } else { const int j = it - nsplit;
          gemm_tile<true>(tx, (const float*)(p.ws + OFF_SSQ), (const bf16_t*)(p.ws + OFF_A1), DM, (const bf16_t*)(p.ws + OFF_WOUT), DM, DM, (j / 8) * 128, (j % 8) * 128, smem, epi);
        }
      }
    } break;
    case PH_NORM2: {
      norm_rows(tix, p, layer, 1, bid, nb, (ctx_out ? T_ : L_) / 8);
    } break;
    case PH_FFN1: {
      Epi256SwiGLU epi{(bf16_t*)(p.ws + OFF_U)};
      const int total = (ctx_out ? 65 : 64) * 44;
      for (int it = bid; it < total; it += nb) {
        int tx = tix; asm volatile("" : "+v"(tx));
#ifdef PROBE_NOLOAD
        if (!last_rep) gemm_tile256<false, true>(tx, nullptr, (const bf16_t*)(p.ws + OFF_A1), DM, (const bf16_t*)(p.ws + OFF_WGU), DM, DM, (it / 44) * 256, (it % 44) * 128, smem, epi); else
#endif
        gemm_tile256<false>(tx, nullptr, (const bf16_t*)(p.ws + OFF_A1), DM, (const bf16_t*)(p.ws + OFF_WGU), DM, DM, (it / 44) * 256, (it % 44) * 128, smem, epi);
      }
    } break;
    case PH_FFN2: {
      Epi256Resid epi{p.out, p.out, MOD + (layer * 2 + 0) * 6144 + 5 * DM};
      Epi256CtxAtomic epc{(float*)(p.ws + OFF_XC), MOD + (layer * 2 + 1) * 6144 + 5 * DM};
      const int nsplit = ctx_out ? 32 : 0;
      const int total = nsplit + 64 * 8;
      for (int it = bid; it < total; it += nb) {
        int tx = tix; asm volatile("" : "+v"(tx));
        if (it < nsplit) { const int tile = it >> 2, kq = it & 3;
          gemm_tile256<false>(tx, nullptr, (const bf16_t*)(p.ws + OFF_U), FH, (const bf16_t*)(p.ws + OFF_WD), FH, FH / 4, L_, tile * 128, smem, epc, kq * (FH / 4));
        } else { const int j = it - nsplit;
          gemm_tile256<false>(tx, nullptr, (const bf16_t*)(p.ws + OFF_U), FH, (const bf16_t*)(p.ws + OFF_WD), FH, FH, (j / 8) * 256, (j % 8) * 128, smem, epi);
        }
      }
    } break;
    case PH_FINAL: {
      norm_rows(tix, p, 1, 2, bid, nb, L_ / 8);
    } break;
  }
}

#define XB_TMO      128
#define XB_XCNT(j)  (256  + 64 * (j))
#define XB_XSUB(j)  (1280 + 64 * (j))
#define XB_XGEN(j)  (2304 + 64 * (j))
#define XB_TOP      3328
#define XB_TOPGEN   3392
#define XB_SPIN_CAP (1u << 22)
DI unsigned xb_ld(unsigned* p) { return __hip_atomic_load(p, __ATOMIC_RELAXED, __HIP_MEMORY_SCOPE_AGENT); }
DI unsigned xb_add(unsigned* p, unsigned v) { return __hip_atomic_fetch_add(p, v, __ATOMIC_RELAXED, __HIP_MEMORY_SCOPE_AGENT); }
DI unsigned xb_xcc_id() { return (unsigned)__builtin_amdgcn_s_getreg((3 << 11) | 20) & 0xFu; }
#define XB_SPIN(cond, bar) do { unsigned _sp = 0; while (cond) { __builtin_amdgcn_s_sleep(1); \
    if ((++_sp & 255u) == 0u) { if (xb_ld(&(bar)[XB_TMO])) break; if (_sp > XB_SPIN_CAP) { atomicAdd(&(bar)[XB_TMO], 1u); break; } } } } while (0)
DI void xb_complete(unsigned* bar, unsigned x, unsigned G, unsigned& nloc, unsigned& nx) {
  unsigned sum, cnt, mine, sp = 0u;
  for (;;) {
    sum = 0u; cnt = 0u; mine = 0u;
#pragma unroll
    for (unsigned j = 0; j < 16; ++j) { const unsigned c = xb_ld(&bar[XB_XCNT(j)]); sum += c; cnt += (c > 0u) ? 1u : 0u; mine = (j == x) ? c : mine; }
    if (sum == G) break;
    __builtin_amdgcn_s_sleep(1);
    if ((++sp & 255u) == 0u) { if (xb_ld(&bar[XB_TMO])) break; if (sp > XB_SPIN_CAP) { atomicAdd(&bar[XB_TMO], 1u); break; } }
  }
  nloc = mine > 0u ? mine : 1u; nx = cnt > 0u ? cnt : 1u;
}
DI void grid_barrier(unsigned* bar, volatile unsigned* st, unsigned x, unsigned G) {
  asm volatile("s_waitcnt vmcnt(0)" ::: "memory");
  __syncthreads();
  if (threadIdx.x == 0) {
    __builtin_amdgcn_s_waitcnt(0);
    unsigned nloc = st[0], nx = st[1];
    if (nloc == 0u) { xb_complete(bar, x, G, nloc, nx); st[0] = nloc; st[1] = nx; }
    const unsigned old = xb_add(&bar[XB_XSUB(x)], 1u);
    const unsigned gen = old / nloc;
    if (old + 1u == (gen + 1u) * nloc) {
      __builtin_amdgcn_fence(__ATOMIC_RELEASE, "agent");
      asm volatile("s_waitcnt vmcnt(0)" ::: "memory");
      const unsigned og = xb_add(&bar[XB_TOP], 1u);
      const unsigned tg = og / nx;
      if (og + 1u == (tg + 1u) * nx) xb_add(&bar[XB_TOPGEN], 1u);
      else XB_SPIN(xb_ld(&bar[XB_TOPGEN]) == tg, bar);
      __builtin_amdgcn_fence(__ATOMIC_ACQUIRE, "agent");
      xb_add(&bar[XB_XGEN(x)], 1u);
      asm volatile("s_waitcnt vmcnt(0)" ::: "memory");
    } else {
      XB_SPIN(xb_ld(&bar[XB_XGEN(x)]) == gen, bar);
      __builtin_amdgcn_fence(__ATOMIC_ACQUIRE, "agent");
      asm volatile("s_waitcnt vmcnt(0)" ::: "memory");
    }
  }
  __syncthreads();
}

#if MULTI_LAUNCH
extern __shared__ __attribute__((aligned(16))) char smem[];
template <int PH> __global__ void __launch_bounds__(NT, 2) phase_kernel(Params p, int layer) {
  run_phase(p, PH, layer, blockIdx.x, gridDim.x, smem);
}
template <int PH> static void launch_phase(const Params& p, int layer, hipStream_t stream) {
  (void)hipFuncSetAttribute((const void*)phase_kernel<PH>, hipFuncAttributeMaxDynamicSharedMemorySize, SMEM_BYTES);
  phase_kernel<PH><<<1024, NT, SMEM_BYTES, stream>>>(p, layer);
}
#else
extern __shared__ __attribute__((aligned(16))) char smem[];
__global__ void __launch_bounds__(NT, 2) mega_kernel(Params p) {
  cg::grid_group grid = cg::this_grid();
  const int bid = blockIdx.x, nb = gridDim.x;
  unsigned* bar = (unsigned*)(p.ws + OFF_BAR);
  volatile unsigned* st = (volatile unsigned*)(smem + SMEM_BYTES);
  if (threadIdx.x == 0) { st[0] = 0u; st[1] = 0u; }
  const unsigned xcc = xb_xcc_id();
  if (threadIdx.x == 0) (void)xb_add(&bar[XB_XCNT(xcc)], 1u);
  if (p.ws == nullptr) grid.sync();
  run_phase(p, PH_INIT, 0, bid, nb, smem);
  grid_barrier(bar, st, xcc, (unsigned)nb);
  for (int layer = 0; layer < 2; ++layer) {
    for (int ph = PH_NORM1; ph <= PH_FFN2; ++ph) {
#ifdef DUP_MASK
      const int reps = 1 + ((DUP_MASK >> ph) & 1);
#else
      const int reps = 1;
#endif
#pragma unroll 1
      for (int rep = 0; rep < reps; ++rep) {
        run_phase(p, ph, layer, bid, nb, smem, rep == reps - 1);
        grid_barrier(bar, st, xcc, (unsigned)nb);
      }
    }
  }
#ifdef EXTRA_SYNCS
#pragma unroll 1
  for (int i = 0; i < EXTRA_SYNCS; ++i) grid_barrier(bar, st, xcc, (unsigned)nb);
#endif
  run_phase(p, PH_FINAL, 1, bid, nb, smem);
}
#endif

extern "C" void kernel_launch(void* const* d_in, const int* in_sizes, int n_in, void* d_out, int out_size, void* d_ws, size_t ws_size,
                              hipStream_t stream) {
  Params p{};
  const float** pf = (const float**)&p;
  for (int i = 0; i < 23; ++i) pf[i] = (const float*)d_in[i];
  p.out = (float*)d_out;
  p.ws = (char*)d_ws;
#if MULTI_LAUNCH
  launch_phase<PH_INIT>(p, 0, stream);
  for (int layer = 0; layer < 2; ++layer) {
    launch_phase<PH_NORM1>(p, layer, stream); launch_phase<PH_INPROJ>(p, layer, stream); launch_phase<PH_PREP>(p, layer, stream);
    launch_phase<PH_MIX1>(p, layer, stream); launch_phase<PH_SCAN>(p, layer, stream); launch_phase<PH_S3>(p, layer, stream);
    launch_phase<PH_OUTPROJ>(p, layer, stream); launch_phase<PH_NORM2>(p, layer, stream); launch_phase<PH_FFN1>(p, layer, stream);
    launch_phase<PH_FFN2>(p, layer, stream);
  }
  launch_phase<PH_FINAL>(p, 1, stream);
#else
  static int grid_blocks = 0;
  if (!grid_blocks) {
    int dev = 0, cus = 0, per_cu = 0;
    (void)hipGetDevice(&dev);
    (void)hipDeviceGetAttribute(&cus, hipDeviceAttributeMultiprocessorCount, dev);
    (void)hipFuncSetAttribute((const void*)mega_kernel, hipFuncAttributeMaxDynamicSharedMemorySize, SMEM_BYTES + 16);
    (void)hipOccupancyMaxActiveBlocksPerMultiprocessor(&per_cu, mega_kernel, NT, SMEM_BYTES + 16);
    if (per_cu > 2) per_cu = 2;
    grid_blocks = cus * per_cu;
  }
  (void)hipMemsetAsync((char*)d_ws + OFF_BAR, 0, 64 * 256, stream);
  void* args[] = {&p};
  hipError_t e = hipLaunchCooperativeKernel((void*)mega_kernel, dim3(grid_blocks), dim3(NT), args, SMEM_BYTES + 16, stream);
  if (e != hipSuccess) fprintf(stderr, "cooperative launch failed: %s (grid %d)\n", hipGetErrorString(e), grid_blocks);
#endif
}
```

```cpp
#include <hip/hip_runtime.h>
#include <hip/hip_cooperative_groups.h>
#include <cstdio>
#include <cstdint>
namespace cg = cooperative_groups;

#ifndef MULTI_LAUNCH
#define MULTI_LAUNCH 0
#endif

#define DI __device__ __forceinline__
typedef unsigned short bf16_t;
typedef short bf16x8 __attribute__((ext_vector_type(8)));
typedef short bf16x4 __attribute__((ext_vector_type(4)));
typedef float f32x16 __attribute__((ext_vector_type(16)));
typedef float f32x4 __attribute__((ext_vector_type(4)));
typedef float f32x2 __attribute__((ext_vector_type(2)));
typedef unsigned u32x4 __attribute__((ext_vector_type(4)));
typedef unsigned u32x2 __attribute__((ext_vector_type(2)));
typedef __bf16 bf16v2 __attribute__((ext_vector_type(2)));

#define MFMA32(a, b, c) __builtin_amdgcn_mfma_f32_32x32x16_bf16((a), (b), (c), 0, 0, 0)
#define MFMA16(a, b, c) __builtin_amdgcn_mfma_f32_16x16x32_bf16((a), (b), (c), 0, 0, 0)

constexpr int L_ = 16384, LC_ = 256, T_ = 16640, DM = 1024, NIN = 2832, NINP = 2944, FH = 2816, NCH = 130;
constexpr int NT = 256;
constexpr float EPSF = 1e-6f;
constexpr float LOG2E = 1.4426950408889634f;
constexpr int SMEM_BYTES = 73728;

constexpr size_t al256(size_t x) { return (x + 255) & ~(size_t)255; }
constexpr size_t OFF_WIN = 0;
constexpr size_t OFF_WOUT = OFF_WIN + al256((size_t)NINP * DM * 2);
constexpr size_t OFF_WGU = OFF_WOUT + al256((size_t)DM * DM * 2);
constexpr size_t OFF_WD = OFF_WGU + al256((size_t)2 * FH * DM * 2);
constexpr size_t OFF_MOD = OFF_WD + al256((size_t)DM * FH * 2);
constexpr size_t OFF_ROPE = OFF_MOD + al256((size_t)2 * 2 * 6144 * 4);
constexpr size_t OFF_XC = OFF_ROPE + al256((size_t)256 * 16 * 8);
constexpr size_t OFF_A1 = OFF_XC + al256((size_t)LC_ * DM * 4);
constexpr size_t OFF_U = OFF_A1 + al256((size_t)T_ * DM * 2);
constexpr size_t OFF_DTRAW = OFF_U + al256((size_t)T_ * NIN * 2);
constexpr size_t OFF_DT = OFF_DTRAW + al256((size_t)T_ * 16 * 4);
constexpr size_t OFF_ACUM = OFF_DT + al256((size_t)T_ * 16 * 4);
constexpr size_t OFF_XBT = OFF_ACUM + al256((size_t)T_ * 16 * 4);
constexpr size_t OFF_BC = OFF_XBT + al256((size_t)NCH * 768 * 128 * 2);
constexpr size_t OFF_QG = OFF_BC + al256((size_t)T_ * 512 * 2);
constexpr size_t OFF_KG = OFF_QG + al256((size_t)T_ * 256 * 2);
constexpr size_t OFF_VGT = OFF_KG + al256((size_t)T_ * 128 * 2);
constexpr size_t OFF_VNT = OFF_VGT + al256((size_t)T_ * 128 * 2);
constexpr size_t OFF_ST = OFF_VNT + al256((size_t)T_ * 256 * 2);
constexpr size_t OFF_CDEC = OFF_ST + al256((size_t)16 * NCH * 8192 * 2);
constexpr size_t OFF_SSQ = OFF_CDEC + al256((size_t)16 * NCH * 4);
constexpr size_t OFF_BAR = OFF_SSQ + al256((size_t)T_ * 4);
constexpr size_t WS_TOTAL = OFF_BAR + 64 * 256;
static_assert(WS_TOTAL <= (size_t)256 * 1024 * 1024, "workspace too large");

struct Params {
  const float *x, *c, *ctx, *c_ctx, *mod_w, *mod_b, *norm_attn_w, *norm_ffn_w, *w_in, *na_rpb, *conv_w, *conv_b, *dt_bias, *a_log,
      *ssd_d, *ssd_norm_w, *q_norm_w, *k_norm_w, *w_out, *w_gate, *w_up, *w_down, *final_norm_w;
  float* out;
  char* ws;
};

DI unsigned pack2(float lo, float hi) { f32x2 v = {lo, hi}; return __builtin_bit_cast(unsigned, __builtin_convertvector(v, bf16v2)); }
DI bf16_t f2bf(float x) { return (bf16_t)(pack2(x, 0.f) & 0xffffu); }
DI float bf2f(bf16_t v) { return __uint_as_float(((unsigned)v) << 16); }
DI float bflo(unsigned u) { return __uint_as_float(u << 16); }
DI float bfhi(unsigned u) { return __uint_as_float(u & 0xffff0000u); }
DI int crow(int reg, int hh) { return (reg & 3) + 8 * (reg >> 2) + 4 * hh; }
DI float siluf(float x) { return x * __builtin_amdgcn_rcpf(1.f + __expf(-x)); }
DI f32x16 zero16() { f32x16 z; for (int i = 0; i < 16; ++i) z[i] = 0.f; return z; }
template <int S> DI bf16x8 pack8(const f32x16& x) {
  u32x4 p;
  p[0] = pack2(x[8 * S + 0], x[8 * S + 1]); p[1] = pack2(x[8 * S + 2], x[8 * S + 3]);
  p[2] = pack2(x[8 * S + 4], x[8 * S + 5]); p[3] = pack2(x[8 * S + 6], x[8 * S + 7]);
  return __builtin_bit_cast(bf16x8, p);
}
DI bf16x8 cat44(u32x2 lo, u32x2 hi) { u32x4 p = {lo[0], lo[1], hi[0], hi[1]}; return __builtin_bit_cast(bf16x8, p); }
DI float shx(float v, int mask, int lane) { return __int_as_float(__builtin_amdgcn_ds_bpermute((lane ^ mask) << 2, __float_as_int(v))); }
DI float wave_sum(float v, int lane) {
#pragma unroll
  for (int o = 32; o > 0; o >>= 1) v += shx(v, o, lane);
  return v;
}

DI void mod_item(int tix, const Params& p, int it, char* smem) {
  const int tid = tix, layer = it / 96, cg64 = it % 96, col = tid & 63, kq = tid >> 6;
  const float* W = p.mod_w + (size_t)layer * DM * 6144 + cg64 * 64 + col;
  float* sc = (float*)smem;
  float* red = sc + 2048;
  __syncthreads();
  for (int i = tid; i < 1024; i += NT) { sc[i] = siluf(p.c[i]); sc[1024 + i] = siluf(p.c_ctx[i]); }
  __syncthreads();
  float a0 = 0.f, a1 = 0.f;
#pragma unroll 1
  for (int k0 = kq * 256; k0 < kq * 256 + 256; k0 += 16) {
    float w[16];
#pragma unroll
    for (int j = 0; j < 16; ++j) w[j] = W[(size_t)(k0 + j) * 6144];
#pragma unroll
    for (int j = 0; j < 16; ++j) { a0 += sc[k0 + j] * w[j]; a1 += sc[1024 + k0 + j] * w[j]; }
  }
  red[(0 * 4 + kq) * 64 + col] = a0; red[(1 * 4 + kq) * 64 + col] = a1;
  __syncthreads();
  if (tid < 128) {
    const int src = tid >> 6;
    float s = red[(src * 4 + 0) * 64 + col] + red[(src * 4 + 1) * 64 + col] + red[(src * 4 + 2) * 64 + col] + red[(src * 4 + 3) * 64 + col];
    s += p.mod_b[layer * 6144 + cg64 * 64 + col];
    float* MOD = (float*)(p.ws + OFF_MOD);
    MOD[(layer * 2 + src) * 6144 + cg64 * 64 + col] = s;
  }
}
DI void rope_item(int tix, const Params& p, int it) {
  const int e = it * NT + tix;
  const int pos = e >> 4, j = e & 15;
  const double freq = exp2(-(double)j * (13.287712379549449 / 16.0));
  double rv = (double)pos * freq * 0.15915494309189535;
  rv -= floor(rv);
  const float fr = (float)rv;
  f32x2* R = (f32x2*)(p.ws + OFF_ROPE);
  f32x2 cs = {__builtin_amdgcn_cosf(fr), __builtin_amdgcn_sinf(fr)};
  R[e] = cs;
}

DI void wconv_tile(int tix, const float* __restrict__ src0, const float* __restrict__ src1, int ldsrc, int ncols_valid, bf16_t* __restrict__ dst, int K,
                   int nt, int kt, int mode, char* smem) {
  float* tile = (float*)smem;
  const int tid = tix, cn = tid & 63, rq = tid >> 6;
  __syncthreads();
  for (int i = 0; i < 16; ++i) {
    const int k = i * 4 + rq;
    float v;
    if (mode == 0) { const int n = nt * 64 + cn; v = (n < ncols_valid) ? src0[(size_t)(kt * 64 + k) * ldsrc + n] : 0.f; }
    else { const int unit = nt * 32 + (cn & 31); v = ((cn >> 5) ? src1 : src0)[(size_t)(kt * 64 + k) * ldsrc + unit]; }
    tile[k * 65 + cn] = v;
  }
  __syncthreads();
  for (int i = 0; i < 16; ++i) {
    const int n = i * 4 + rq, k = cn;
    dst[(size_t)(nt * 64 + n) * K + kt * 64 + k] = f2bf(tile[k * 65 + n]);
  }
}
constexpr int WC_IN = 46 * 16, WC_OUT = 16 * 16, WC_GU = 88 * 16, WC_D = 16 * 44, WC_TOTAL = WC_IN + WC_OUT + WC_GU + WC_D;
DI void wconv_item(int tix, const Params& p, int layer, int it, char* smem) {
  if (it < WC_IN) { wconv_tile(tix, p.w_in + (size_t)layer * DM * NIN, nullptr, NIN, NIN, (bf16_t*)(p.ws + OFF_WIN), DM, it / 16, it % 16, 0, smem); return; }
  it -= WC_IN;
  if (it < WC_OUT) { wconv_tile(tix, p.w_out + (size_t)layer * DM * DM, nullptr, DM, DM, (bf16_t*)(p.ws + OFF_WOUT), DM, it / 16, it % 16, 0, smem); return; }
  it -= WC_OUT;
  if (it < WC_GU) { wconv_tile(tix, p.w_gate + (size_t)layer * DM * FH, p.w_up + (size_t)layer * DM * FH, FH, FH, (bf16_t*)(p.ws + OFF_WGU), DM, it / 16, it % 16, 1, smem); return; }
  it -= WC_GU;
  wconv_tile(tix, p.w_down + (size_t)layer * FH * DM, nullptr, DM, DM, (bf16_t*)(p.ws + OFF_WD), FH, it / 44, it % 44, 0, smem);
}

DI void norm_item(int tix, const Params& p, int layer, int which, int it) {
  const int lane = tix & 63, wid = tix >> 6;
  const float* MOD = (const float*)(p.ws + OFF_MOD);
  const float* XC = (const float*)(p.ws + OFF_XC);
  bf16_t* A1 = (bf16_t*)(p.ws + OFF_A1);
  f32x4 v[2][4];
#pragma unroll
  for (int rr = 0; rr < 2; ++rr) {
    const int row = it * 8 + wid * 2 + rr;
    const float* src;
    if (row < L_) src = ((layer == 0 && which == 0) ? p.x : p.out) + (size_t)row * DM;
    else src = ((layer == 0 && which == 0) ? p.ctx : XC) + (size_t)(row - L_) * DM;
#pragma unroll
    for (int i = 0; i < 4; ++i) v[rr][i] = *(const f32x4*)(src + i * 256 + lane * 4);
  }
#pragma unroll
  for (int rr = 0; rr < 2; ++rr) {
    const int row = it * 8 + wid * 2 + rr;
    float ss = 0.f;
#pragma unroll
    for (int i = 0; i < 4; ++i) ss += v[rr][i][0] * v[rr][i][0] + v[rr][i][1] * v[rr][i][1] + v[rr][i][2] * v[rr][i][2] + v[rr][i][3] * v[rr][i][3];
    ss = wave_sum(ss, lane);
    const float rstd = rsqrtf(ss * (1.f / DM) + EPSF);
    if (which == 2) {
      float* dst = p.out + (size_t)row * DM;
#pragma unroll
      for (int i = 0; i < 4; ++i) {
        const f32x4 w = *(const f32x4*)(p.final_norm_w + i * 256 + lane * 4);
        f32x4 o; for (int j = 0; j < 4; ++j) o[j] = v[rr][i][j] * rstd * w[j];
        *(f32x4*)(dst + i * 256 + lane * 4) = o;
      }
    } else {
      const float* nw = (which == 0 ? p.norm_attn_w : p.norm_ffn_w) + layer * DM;
      const float* md = MOD + (layer * 2 + (row >= L_ ? 1 : 0)) * 6144 + (which == 0 ? 0 : 3 * DM);
#pragma unroll
      for (int i = 0; i < 4; ++i) {
        const int c = i * 256 + lane * 4;
        const f32x4 w = *(const f32x4*)(nw + c), sh = *(const f32x4*)(md + c), sc = *(const f32x4*)(md + DM + c);
        float o[4]; for (int j = 0; j < 4; ++j) o[j] = v[rr][i][j] * rstd * w[j] * (1.f + sc[j]) + sh[j];
        u32x2 pk = {pack2(o[0], o[1]), pack2(o[2], o[3])};
        *(u32x2*)(A1 + (size_t)row * DM + c) = pk;
      }
    }
  }
}

template <bool SCALE_A, bool NOLOAD = false, class Epi>
DI void gemm_tile(int tix, const float* __restrict__ SSQ, const bf16_t* __restrict__ A, int lda, const bf16_t* __restrict__ Bt, int ldb, int K, int m0, int n0, char* smem, const Epi& epi, int kbeg = 0) {
  const int tid = tix, lane = tid & 63, wid = tid >> 6, wr = wid >> 1, wc = wid & 1, fr = lane & 15, fq = lane >> 4;
  bf16_t* sbuf = (bf16_t*)smem;
  constexpr int STG = 2 * 128 * 72;
  f32x4 acc[4][4];
#pragma unroll
  for (int mi = 0; mi < 4; ++mi)
#pragma unroll
    for (int ni = 0; ni < 4; ++ni) acc[mi][ni] = (f32x4){0.f, 0.f, 0.f, 0.f};
  const int lrow = tid >> 3, lcol = (tid & 7) * 8;
  const bf16_t* ga = A + (size_t)(m0 + lrow) * lda + lcol + kbeg;
  const bf16_t* gb = Bt + (size_t)(n0 + lrow) * ldb + lcol + kbeg;
  float rs[4] = {1.f, 1.f, 1.f, 1.f};
  if (SCALE_A) {
#pragma unroll
    for (int i = 0; i < 4; ++i) rs[i] = rsqrtf(SSQ[m0 + lrow + 32 * i] * (1.f / 512.f) + EPSF);
  }
  u32x4 ra[4], rb[4];
  auto gload = [&](int k0) {
#pragma unroll
    for (int i = 0; i < 4; ++i) { ra[i] = *(const u32x4*)(ga + (size_t)(32 * i) * lda + k0); rb[i] = *(const u32x4*)(gb + (size_t)(32 * i) * ldb + k0); }
  };
  auto lstore = [&](int stage, int k0) {
    if (SCALE_A && kbeg + k0 >= 256 && kbeg + k0 < 768) {
#pragma unroll
      for (int i = 0; i < 4; ++i)
#pragma unroll
        for (int q = 0; q < 4; ++q) ra[i][q] = pack2(bflo(ra[i][q]) * rs[i], bfhi(ra[i][q]) * rs[i]);
    }
    bf16_t* sA = sbuf + stage * STG; bf16_t* sB = sA + 128 * 72;
#pragma unroll
    for (int i = 0; i < 4; ++i) { *(u32x4*)(sA + (lrow + 32 * i) * 72 + lcol) = ra[i]; *(u32x4*)(sB + (lrow + 32 * i) * 72 + lcol) = rb[i]; }
  };
  const int nk = K >> 6;
  gload(0);
  __syncthreads();
  lstore(0, 0);
  if (nk > 1) gload(64);
  __syncthreads();
  for (int kt = 0; kt < nk; ++kt) {
    const int cur = kt & 1;
    if (kt + 1 < nk) lstore(cur ^ 1, (kt + 1) * 64);
    if (!NOLOAD && kt + 2 < nk) gload((kt + 2) * 64);
    __builtin_amdgcn_sched_barrier(0);
    const bf16_t* sA = sbuf + cur * STG + (64 * wr + fr) * 72 + 8 * fq;
    const bf16_t* sB = sbuf + cur * STG + 128 * 72 + (64 * wc + fr) * 72 + 8 * fq;
#pragma unroll
    for (int ks = 0; ks < 2; ++ks) {
      bf16x8 a[4], b[4];
#pragma unroll
      for (int i = 0; i < 4; ++i) { a[i] = *(const bf16x8*)(sA + 16 * i * 72 + 32 * ks); b[i] = *(const bf16x8*)(sB + 16 * i * 72 + 32 * ks); }
#pragma unroll
      for (int mi = 0; mi < 4; ++mi)
#pragma unroll
        for (int ni = 0; ni < 4; ++ni) acc[mi][ni] = MFMA16(b[ni], a[mi], acc[mi][ni]);
    }
    __syncthreads();
  }
  epi(acc, m0 + 64 * wr, n0 + 64 * wc, fr, fq);
}

struct EpiInProj {
  bf16_t* U; float* DTRAW;
  DI void operator()(const f32x4 (&acc)[4][4], int mrow, int ncol, int fr, int fq) const {
#pragma unroll
    for (int mi = 0; mi < 4; ++mi) {
      const int row = mrow + 16 * mi + fr;
#pragma unroll
      for (int ni = 0; ni < 4; ++ni) {
        const int col = ncol + 16 * ni + 4 * fq;
        if (col < NIN) {
          u32x2 pk = {pack2(acc[mi][ni][0], acc[mi][ni][1]), pack2(acc[mi][ni][2], acc[mi][ni][3])};
          *(u32x2*)(U + (size_t)row * NIN + col) = pk;
          if (col >= 2304 && col < 2320) *(f32x4*)(DTRAW + row * 16 + col - 2304) = acc[mi][ni];
        }
      }
    }
  }
};
struct EpiResid {
  const float* old_lat; const float* old_ctx; float* new_lat; float* new_ctx; const float* gate_lat; const float* gate_ctx;
  DI void operator()(const f32x4 (&acc)[4][4], int mrow, int ncol, int fr, int fq) const {
#pragma unroll
    for (int mi = 0; mi < 4; ++mi) {
      const int row = mrow + 16 * mi + fr;
      const bool lat = row < L_;
      const float* op = lat ? old_lat + (size_t)row * DM : old_ctx + (size_t)(row - L_) * DM;
      float* np = lat ? new_lat + (size_t)row * DM : new_ctx + (size_t)(row - L_) * DM;
      const float* gp = lat ? gate_lat : gate_ctx;
#pragma unroll
      for (int ni = 0; ni < 4; ++ni) {
        const int col = ncol + 16 * ni + 4 * fq;
        const f32x4 o = *(const f32x4*)(op + col), gt = *(const f32x4*)(gp + col);
        *(f32x4*)(np + col) = o + gt * acc[mi][ni];
      }
    }
  }
};
struct EpiCtxAtomic {
  float* xc; const float* gate;
  DI void operator()(const f32x4 (&acc)[4][4], int mrow, int ncol, int fr, int fq) const {
#pragma unroll
    for (int mi = 0; mi < 4; ++mi) {
      float* np = xc + (size_t)(mrow + 16 * mi + fr - L_) * DM;
#pragma unroll
      for (int ni = 0; ni < 4; ++ni) {
        const int col = ncol + 16 * ni + 4 * fq;
        const f32x4 gt = *(const f32x4*)(gate + col);
#pragma unroll
        for (int j = 0; j < 4; ++j) atomicAdd(np + col + j, gt[j] * acc[mi][ni][j]);
      }
    }
  }
};
struct EpiSwiGLU {
  bf16_t* ACT;
  DI void operator()(const f32x4 (&acc)[4][4], int mrow, int ncol, int fr, int fq) const {
    const int unit0 = (ncol >> 1) + 4 * fq;
#pragma unroll
    for (int mi = 0; mi < 4; ++mi) {
      const int row = mrow + 16 * mi + fr;
#pragma unroll
      for (int ni = 0; ni < 2; ++ni) {
        float o[4];
#pragma unroll
        for (int j = 0; j < 4; ++j) o[j] = siluf(acc[mi][ni][j]) * acc[mi][ni + 2][j];
        u32x2 pk = {pack2(o[0], o[1]), pack2(o[2], o[3])};
        *(u32x2*)(ACT + (size_t)row * FH + unit0 + 16 * ni) = pk;
      }
    }
  }
};

template <bool SCALE_A, bool NOLOAD = false, class Epi>
DI void gemm_tile256(int tix, const float* __restrict__ SSQ, const bf16_t* __restrict__ A, int lda, const bf16_t* __restrict__ Bt, int ldb, int K, int m0, int n0, char* smem, const Epi& epi, int kbeg = 0, int scale_after = -1, bool kperm = false) {
  const int tid = tix, lane = tid & 63, wid = tid >> 6, wr = wid >> 1, wc = wid & 1, fr = lane & 15, fq = lane >> 4;
  bf16_t* sA = (bf16_t*)smem;
  bf16_t* sB = sA + 256 * 72;
  f32x4 acc[8][4];
#pragma unroll
  for (int mi = 0; mi < 8; ++mi)
#pragma unroll
    for (int ni = 0; ni < 4; ++ni) acc[mi][ni] = (f32x4){0.f, 0.f, 0.f, 0.f};
  const int lrow = tid >> 3, lcol = (tid & 7) * 8;
  const bf16_t* ga = A + (size_t)(m0 + lrow) * lda + lcol + kbeg;
  const bf16_t* gb = Bt + (size_t)(n0 + lrow) * ldb + lcol + kbeg;
  u32x4 ra[8], rb[4];
  auto gload = [&](int k0) {
#pragma unroll
    for (int i = 0; i < 8; ++i) ra[i] = *(const u32x4*)(ga + (size_t)(32 * i) * lda + k0);
#pragma unroll
    for (int i = 0; i < 4; ++i) rb[i] = *(const u32x4*)(gb + (size_t)(32 * i) * ldb + k0);
  };
  auto lstore = [&](int k0) {
#pragma unroll
    for (int i = 0; i < 8; ++i) *(u32x4*)(sA + (lrow + 32 * i) * 72 + lcol) = ra[i];
#pragma unroll
    for (int i = 0; i < 4; ++i) *(u32x4*)(sB + (lrow + 32 * i) * 72 + lcol) = rb[i];
  };
  const int nk = K >> 6;
  auto kof = [&](int kt) -> int { return kperm ? (kt < 8 ? 256 + 64 * kt : (kt < 12 ? 64 * (kt - 8) : 768 + 64 * (kt - 12))) : 64 * kt; };
  gload(kof(0));
  for (int kt = 0; kt < nk; ++kt) {
    __syncthreads();
    lstore(kof(kt));
    __syncthreads();
    if (!NOLOAD && kt + 1 < nk) gload(kof(kt + 1));
    const bf16_t* pA = sA + (128 * wr + fr) * 72 + 8 * fq;
    const bf16_t* pB = sB + (64 * wc + fr) * 72 + 8 * fq;
#pragma unroll
    for (int ks = 0; ks < 2; ++ks) {
      bf16x8 b[4];
#pragma unroll
      for (int i = 0; i < 4; ++i) b[i] = *(const bf16x8*)(pB + 16 * i * 72 + 32 * ks);
#pragma unroll
      for (int mh = 0; mh < 4; ++mh) {
        bf16x8 a[2];
#pragma unroll
        for (int i = 0; i < 2; ++i) a[i] = *(const bf16x8*)(pA + 16 * (2 * mh + i) * 72 + 32 * ks);
#pragma unroll
        for (int mi = 0; mi < 2; ++mi)
#pragma unroll
          for (int ni = 0; ni < 4; ++ni) acc[2 * mh + mi][ni] = MFMA16(b[ni], a[mi], acc[2 * mh + mi][ni]);
      }
    }
    if (SCALE_A && kt == scale_after) {
#pragma unroll
      for (int mi = 0; mi < 8; ++mi) {
        const float rs = rsqrtf(SSQ[m0 + 128 * wr + 16 * mi + fr] * (1.f / 512.f) + EPSF);
#pragma unroll
        for (int ni = 0; ni < 4; ++ni) acc[mi][ni] = acc[mi][ni] * rs;
      }
    }
  }
  epi(acc, m0 + 128 * wr, n0 + 64 * wc, fr, fq);
}

struct Epi256InProj {
  bf16_t* U; float* DTRAW;
  DI void operator()(const f32x4 (&acc)[8][4], int mrow, int ncol, int fr, int fq) const {
#pragma unroll
    for (int mi = 0; mi < 8; ++mi) {
      const int row = mrow + 16 * mi + fr;
#pragma unroll
      for (int ni = 0; ni < 4; ++ni) {
        const int col = ncol + 16 * ni + 4 * fq;
        if (col < NIN) {
          u32x2 pk = {pack2(acc[mi][ni][0], acc[mi][ni][1]), pack2(acc[mi][ni][2], acc[mi][ni][3])};
          *(u32x2*)(U + (size_t)row * NIN + col) = pk;
          if (col >= 2304 && col < 2320) *(f32x4*)(DTRAW + row * 16 + col - 2304) = acc[mi][ni];
        }
      }
      __builtin_amdgcn_sched_barrier(0);
    }
  }
};
struct Epi256Resid {
  const float* old_lat; float* new_lat; const float* gate_lat;
  DI void operator()(const f32x4 (&acc)[8][4], int mrow, int ncol, int fr, int fq) const {
#pragma unroll
    for (int mi = 0; mi < 8; ++mi) {
      const int row = mrow + 16 * mi + fr;
      const float* op = old_lat + (size_t)row * DM;
      float* np = new_lat + (size_t)row * DM;
#pragma unroll
      for (int ni = 0; ni < 4; ++ni) {
        const int col = ncol + 16 * ni + 4 * fq;
        const f32x4 o = *(const f32x4*)(op + col), gt = *(const f32x4*)(gate_lat + col);
        *(f32x4*)(np + col) = o + gt * acc[mi][ni];
      }
      __builtin_amdgcn_sched_barrier(0);
    }
  }
};
struct Epi256CtxAtomic {
  float* xc; const float* gate;
  DI void operator()(const f32x4 (&acc)[8][4], int mrow, int ncol, int fr, int fq) const {
#pragma unroll
    for (int mi = 0; mi < 8; ++mi) {
      float* np = xc + (size_t)(mrow + 16 * mi + fr - L_) * DM;
#pragma unroll
      for (int ni = 0; ni < 4; ++ni) {
        const int col = ncol + 16 * ni + 4 * fq;
        const f32x4 gt = *(const f32x4*)(gate + col);
#pragma unroll
        for (int j = 0; j < 4; ++j) atomicAdd(np + col + j, gt[j] * acc[mi][ni][j]);
      }
      __builtin_amdgcn_sched_barrier(0);
    }
  }
};
struct Epi256SwiGLU {
  bf16_t* ACT;
  DI void operator()(const f32x4 (&acc)[8][4], int mrow, int ncol, int fr, int fq) const {
    const int unit0 = (ncol >> 1) + 4 * fq;
#pragma unroll
    for (int mi = 0; mi < 8; ++mi) {
      const int row = mrow + 16 * mi + fr;
#pragma unroll
      for (int ni = 0; ni < 2; ++ni) {
        float o[4];
#pragma unroll
        for (int j = 0; j < 4; ++j) o[j] = siluf(acc[mi][ni][j]) * acc[mi][ni + 2][j];
        u32x2 pk = {pack2(o[0], o[1]), pack2(o[2], o[3])};
        *(u32x2*)(ACT + (size_t)row * FH + unit0 + 16 * ni) = pk;
      }
      __builtin_amdgcn_sched_barrier(0);
    }
  }
};

DI void conv_item(int tix, const Params& p, int layer, int it) {
  const int tb = it >> 2, cgp = it & 3;
  const int lane = tix & 63, tg = tix >> 6;
  const bf16_t* U = (const bf16_t*)(p.ws + OFF_U);
  const int c = cgp * 256 + lane * 4;
  const int row0 = tb * 64 + tg * 16;
  const int seq_lo = (row0 < L_) ? 0 : L_, seq_hi = (row0 < L_) ? L_ : T_;
  f32x4 w[5];
#pragma unroll
  for (int j = 0; j < 5; ++j) w[j] = *(const f32x4*)(p.conv_w + ((size_t)layer * 5 + j) * 1024 + c);
  const f32x4 bias = *(const f32x4*)(p.conv_b + layer * 1024 + c);
  u32x2 xr[20];
#pragma unroll
  for (int i = 0; i < 20; ++i) {
    const int row = row0 + i - 2;
    u32x2 z = {0u, 0u};
    xr[i] = (row >= seq_lo && row < seq_hi) ? *(const u32x2*)(U + (size_t)row * NIN + 1280 + c) : z;
  }
  unsigned o[4][8];
  bf16_t* BC = (bf16_t*)(p.ws + OFF_BC);
#pragma unroll
  for (int i = 0; i < 16; i += 2) {
    float y0[4], y1[4];
#pragma unroll
    for (int q = 0; q < 4; ++q) { y0[q] = bias[q]; y1[q] = bias[q]; }
#pragma unroll
    for (int j = 0; j < 5; ++j) {
      const u32x2 a = xr[i + j], b = xr[i + 1 + j];
      y0[0] += w[j][0] * bflo(a[0]); y0[1] += w[j][1] * bfhi(a[0]); y0[2] += w[j][2] * bflo(a[1]); y0[3] += w[j][3] * bfhi(a[1]);
      y1[0] += w[j][0] * bflo(b[0]); y1[1] += w[j][1] * bfhi(b[0]); y1[2] += w[j][2] * bflo(b[1]); y1[3] += w[j][3] * bfhi(b[1]);
    }
#pragma unroll
    for (int q = 0; q < 4; ++q) { y0[q] = siluf(y0[q]); y1[q] = siluf(y1[q]); o[q][i >> 1] = pack2(y0[q], y1[q]); }
    if (cgp >= 2) {
      u32x2 t0 = {pack2(y0[0], y0[1]), pack2(y0[2], y0[3])}, t1 = {pack2(y1[0], y1[1]), pack2(y1[2], y1[3])};
      *(u32x2*)(BC + (size_t)(row0 + i) * 512 + (c - 512)) = t0;
      *(u32x2*)(BC + (size_t)(row0 + i + 1) * 512 + (c - 512)) = t1;
    }
  }
  if (cgp < 3) {
    bf16_t* XBT = (bf16_t*)(p.ws + OFF_XBT);
    const int gc = row0 >> 7, tl = row0 & 127;
#pragma unroll
    for (int q = 0; q < 4; ++q) {
      u32x4 lo = {o[q][0], o[q][1], o[q][2], o[q][3]}, hi = {o[q][4], o[q][5], o[q][6], o[q][7]};
      u32x4* d = (u32x4*)(XBT + ((size_t)gc * 768 + c + q) * 128 + tl);
      d[0] = lo; d[1] = hi;
    }
  }
}

DI void dt_item(int tix, const Params& p, int layer, int gc, char* smem) {
  const int tid = tix, lane = tid & 63, wid = tid >> 6;
  const float* DTRAW = (const float*)(p.ws + OFF_DTRAW);
  float* DT = (float*)(p.ws + OFF_DT);
  float* AC = (float*)(p.ws + OFF_ACUM);
  if (tid < 128) ((float*)(p.ws + OFF_SSQ))[gc * 128 + tid] = 0.f;
#pragma unroll
  for (int ci = 0; ci < 4; ++ci) {
    const int col = wid * 4 + ci;
    const int d = col >> 3;
    const float bias = p.dt_bias[layer * 16 + col];
    const float a = -__expf(p.a_log[layer * 16 + col]);
    const int i0 = 2 * lane, i1 = 2 * lane + 1;
    const int t0 = d ? 127 - i0 : i0, t1 = d ? 127 - i1 : i1;
    const size_t r0 = (size_t)(gc * 128 + t0) * 16 + col, r1 = (size_t)(gc * 128 + t1) * 16 + col;
    float x0 = DTRAW[r0] + bias, x1 = DTRAW[r1] + bias;
    const float dt0 = x0 > 20.f ? x0 : log1pf(__expf(x0));
    const float dt1 = x1 > 20.f ? x1 : log1pf(__expf(x1));
    const float v0 = dt0 * a, v1 = dt1 * a;
    float s = v0 + v1, inc = s;
    for (int o = 1; o < 64; o <<= 1) { const float n = __int_as_float(__builtin_amdgcn_ds_bpermute((lane - o) << 2, __float_as_int(inc))); if (lane >= o) inc += n; }
    const float excl = inc - s;
    DT[r0] = dt0; DT[r1] = dt1;
    AC[r0] = excl + v0; AC[r1] = excl + v0 + v1;
  }
}

DI void qk_item(int tix, const Params& p, int layer, int it) {
  const int rid2 = it * NT + tix;
  const int half = rid2 & 1, rowid = rid2 >> 1;
  const int tok = rowid / 6, hsel = rowid - tok * 6;
  const bf16_t* U = (const bf16_t*)(p.ws + OFF_U);
  const f32x2* R = (const f32x2*)(p.ws + OFF_ROPE);
  const u32x4* src = (const u32x4*)(U + (size_t)tok * NIN + 2320 + hsel * 64 + 32 * half);
  float x[32];
  float ss = 0.f;
#pragma unroll
  for (int i = 0; i < 4; ++i) {
    const u32x4 v = src[i];
#pragma unroll
    for (int q = 0; q < 4; ++q) { x[8 * i + 2 * q] = bflo(v[q]); x[8 * i + 2 * q + 1] = bfhi(v[q]); }
  }
#pragma unroll
  for (int i = 0; i < 32; ++i) ss += x[i] * x[i];
  ss += shx(ss, 1, tix & 63);
  const float rstd = rsqrtf(ss * (1.f / 64.f) + EPSF);
  const f32x4* nw = (const f32x4*)((hsel < 4 ? p.q_norm_w : p.k_norm_w) + layer * 64 + 32 * half);
#pragma unroll
  for (int i = 0; i < 8; ++i) {
    const f32x4 w = nw[i];
#pragma unroll
    for (int j = 0; j < 4; ++j) x[4 * i + j] = x[4 * i + j] * rstd * w[j];
  }
  if (tok < L_) {
    const int pos = half ? (tok & 63) : (tok >> 6);
#pragma unroll
    for (int j = 0; j < 16; ++j) {
      const f32x2 cs = R[pos * 16 + j];
      const float a = x[j], b = x[16 + j];
      x[j] = a * cs[0] - b * cs[1];
      x[16 + j] = b * cs[0] + a * cs[1];
    }
  }
  const float sc = hsel < 4 ? 0.125f * LOG2E : 1.f;
  u32x4* dst = (hsel < 4) ? (u32x4*)((bf16_t*)(p.ws + OFF_QG) + (size_t)tok * 256 + hsel * 64 + 32 * half)
                          : (u32x4*)((bf16_t*)(p.ws + OFF_KG) + (size_t)tok * 128 + (hsel - 4) * 64 + 32 * half);
#pragma unroll
  for (int i = 0; i < 4; ++i) {
    u32x4 o;
#pragma unroll
    for (int q = 0; q < 4; ++q) o[q] = pack2(x[8 * i + 2 * q] * sc, x[8 * i + 2 * q + 1] * sc);
    dst[i] = o;
  }
}

DI void vtr_item(int tix, const Params& p, int it) {
  const bf16_t* U = (const bf16_t*)(p.ws + OFF_U);
  int row0, c, col0; bf16_t* dst;
  if (it < 260) { row0 = it * 64 + (tix >> 6) * 16; c = (tix & 63) * 4; col0 = 512; dst = (bf16_t*)(p.ws + OFF_VNT); }
  else { row0 = (it - 260) * 128 + (tix >> 5) * 16; c = (tix & 31) * 4; col0 = 2320 + 384; dst = (bf16_t*)(p.ws + OFF_VGT); }
  u32x2 xr[16];
#pragma unroll
  for (int i = 0; i < 16; ++i) xr[i] = *(const u32x2*)(U + (size_t)(row0 + i) * NIN + col0 + c);
#pragma unroll
  for (int q = 0; q < 4; ++q) {
    unsigned o[8];
#pragma unroll
    for (int i = 0; i < 8; ++i) {
      const unsigned a = xr[2 * i][q >> 1], b = xr[2 * i + 1][q >> 1];
      o[i] = (q & 1) ? ((a >> 16) | (b & 0xffff0000u)) : ((a & 0xffffu) | (b << 16));
    }
    u32x4 lo = {o[0], o[1], o[2], o[3]}, hi = {o[4], o[5], o[6], o[7]};
    u32x4* d = (u32x4*)(dst + (size_t)(c + q) * T_ + row0);
    d[0] = lo; d[1] = hi;
  }
}

struct AttnState { f32x16 o[2]; float m, l; };

template <class KF, class VF, class SF>
DI void attn_tile(AttnState& st, int lane, bool first, float cinv, const bf16x8 (&qf)[4], const KF& kf, const VF& vf, const SF& sf) {
  f32x16 s[2];
  const float init = first ? 0.f : -st.m * cinv;
#pragma unroll
  for (int ks = 0; ks < 2; ++ks) {
#pragma unroll
    for (int i = 0; i < 16; ++i) s[ks][i] = init;
#pragma unroll
    for (int kk = 0; kk < 4; ++kk) s[ks] = MFMA32(kf(ks, kk), qf[kk], s[ks]);
  }
  sf(s);
  if (first) {
    float mx = fmaxf(s[0][0], s[1][0]);
#pragma unroll
    for (int i = 1; i < 16; ++i) mx = fmaxf(mx, fmaxf(s[0][i], s[1][i]));
    mx = fmaxf(mx, shx(mx, 32, lane));
    if (mx == -INFINITY) mx = 0.f;
    st.m = mx;
#pragma unroll
    for (int i = 0; i < 16; ++i) { s[0][i] -= mx; s[1][i] -= mx; }
  }
  float sum = 0.f;
#pragma unroll
  for (int ks = 0; ks < 2; ++ks)
#pragma unroll
    for (int i = 0; i < 16; ++i) { const float pv = __builtin_amdgcn_exp2f(s[ks][i]); s[ks][i] = pv; sum += pv; }
  sum += shx(sum, 32, lane);
  if (__any(sum > 65536.f)) {
    const float delta = sum > 65536.f ? ceilf(__log2f(sum)) : 0.f;
    const float sc = __builtin_amdgcn_exp2f(-delta);
    st.m += delta; st.l *= sc; sum *= sc;
#pragma unroll
    for (int i = 0; i < 16; ++i) { s[0][i] *= sc; s[1][i] *= sc; st.o[0][i] *= sc; st.o[1][i] *= sc; }
  }
  st.l += sum;
#pragma unroll
  for (int ks = 0; ks < 2; ++ks) {
    const bf16x8 p0 = pack8<0>(s[ks]), p1 = pack8<1>(s[ks]);
#pragma unroll
    for (int dt = 0; dt < 2; ++dt) {
      st.o[dt] = MFMA32(vf(dt, ks, 0), p0, st.o[dt]);
      st.o[dt] = MFMA32(vf(dt, ks, 1), p1, st.o[dt]);
    }
  }
}
DI void attn_store(const AttnState& st, bf16_t* __restrict__ dst  , int hh) {
  const float inv = 1.f / st.l;
#pragma unroll
  for (int dt = 0; dt < 2; ++dt)
#pragma unroll
    for (int g = 0; g < 4; ++g) {
      u32x2 pk = {pack2(st.o[dt][4 * g] * inv, st.o[dt][4 * g + 1] * inv), pack2(st.o[dt][4 * g + 2] * inv, st.o[dt][4 * g + 3] * inv)};
      *(u32x2*)(dst + 32 * dt + 8 * g + 4 * hh) = pk;
    }
}

DI void gqa_item(int tix, const Params& p, int qrow0, int g, int kt0, int kt1, char* smem) {
  const int tid = tix, lane = tid & 63, wid = tid >> 6, r = lane & 31, hh = lane >> 5;
  const int head = 2 * g + (wid >> 1), qsub = wid & 1;
  const bf16_t* QG = (const bf16_t*)(p.ws + OFF_QG);
  const bf16_t* KG = (const bf16_t*)(p.ws + OFF_KG);
  const bf16_t* VGT = (const bf16_t*)(p.ws + OFF_VGT);
  bf16_t* Y = (bf16_t*)(p.ws + OFF_A1);
  bf16_t* sbuf = (bf16_t*)smem;
  constexpr int STG = 64 * 72 + 64 * 68;
  const int qrow = qrow0 + 32 * qsub + r;
  bf16x8 qf[4];
#pragma unroll
  for (int kk = 0; kk < 4; ++kk) qf[kk] = *(const bf16x8*)(QG + (size_t)qrow * 256 + head * 64 + 16 * kk + 8 * hh);
  AttnState st; st.o[0] = zero16(); st.o[1] = zero16(); st.m = 0.f; st.l = 0.f;
  const int lrow = tid >> 3, lcol = (tid & 7) * 8;
  const bf16_t* gk = KG + (size_t)lrow * 128 + g * 64 + lcol;
  const bf16_t* gv = VGT + (size_t)(g * 64 + lrow) * T_ + lcol;
  u32x4 rk0[2], rv0[2], rk1[2], rv1[2];
  auto gload = [&](int kt, u32x4 (&rk)[2], u32x4 (&rv)[2]) {
    if (kt < kt1) {
      const size_t key0 = (size_t)kt * 64;
      rk[0] = *(const u32x4*)(gk + key0 * 128); rk[1] = *(const u32x4*)(gk + (key0 + 32) * 128);
      rv[0] = *(const u32x4*)(gv + key0); rv[1] = *(const u32x4*)(gv + (size_t)32 * T_ + key0);
    }
  };
  auto lstore = [&](int stage, const u32x4 (&rk)[2], const u32x4 (&rv)[2]) {
    bf16_t* sK = sbuf + stage * STG; bf16_t* sV = sK + 64 * 72;
    *(u32x4*)(sK + lrow * 72 + lcol) = rk[0]; *(u32x4*)(sK + (lrow + 32) * 72 + lcol) = rk[1];
    u32x2 a = {rv[0][0], rv[0][1]}, b = {rv[0][2], rv[0][3]}, c = {rv[1][0], rv[1][1]}, d = {rv[1][2], rv[1][3]};
    *(u32x2*)(sV + lrow * 68 + lcol) = a; *(u32x2*)(sV + lrow * 68 + lcol + 4) = b;
    *(u32x2*)(sV + (lrow + 32) * 68 + lcol) = c; *(u32x2*)(sV + (lrow + 32) * 68 + lcol + 4) = d;
  };
  auto compute = [&](int stage, bool first) {
    const bf16_t* sK = sbuf + stage * STG; const bf16_t* sV = sK + 64 * 72;
    auto kf = [&](int ks, int kk) -> bf16x8 { return *(const bf16x8*)(sK + (32 * ks + r) * 72 + 16 * kk + 8 * hh); };
    auto vf = [&](int dt, int ks, int step) -> bf16x8 {
      const bf16_t* b = sV + (32 * dt + r) * 68 + 32 * ks + 16 * step + 4 * hh;
      return cat44(*(const u32x2*)b, *(const u32x2*)(b + 8));
    };
    auto sf = [&](f32x16 (&sx)[2]) {};
    attn_tile(st, lane, first, 1.f, qf, kf, vf, sf);
  };
  gload(kt0, rk0, rv0); gload(kt0 + 1, rk1, rv1);
  __syncthreads();
  lstore(0, rk0, rv0);
  gload(kt0 + 2, rk0, rv0);
  __syncthreads();
  for (int kt = kt0; kt < kt1; kt += 2) {
    lstore(1, rk1, rv1);
    gload(kt + 3, rk1, rv1);
    __builtin_amdgcn_sched_barrier(0);
    compute(0, kt == kt0);
    __syncthreads();
    if (kt + 2 < kt1) lstore(0, rk0, rv0);
    gload(kt + 4, rk0, rv0);
    __builtin_amdgcn_sched_barrier(0);
    compute(1, false);
    __syncthreads();
  }
  attn_store(st, Y + (size_t)qrow * DM + 768 + head * 64, hh);
}

DI void na_item(int tix, const Params& p, int layer, int rowidx, int hp, bool is_ctx, char* smem) {
  const int tid = tix, lane = tid & 63, wid = tid >> 6, r = lane & 31, hh = lane >> 5;
  const int head = 2 * hp + (wid >> 1), qsub = wid & 1;
  const bf16_t* U = (const bf16_t*)(p.ws + OFF_U);
  const bf16_t* VNT = (const bf16_t*)(p.ws + OFF_VNT);
  bf16_t* Y = (bf16_t*)(p.ws + OFF_A1);
  float* srpb = (float*)smem;
  __syncthreads();
  for (int i = tid; i < 2 * 465; i += NT) srpb[i] = p.na_rpb[((size_t)layer * 4 + 2 * hp) * 465 + i] * LOG2E;
  __syncthreads();
  const float* myrpb = srpb + (wid >> 1) * 465;
  const int qc = 32 * qsub + r;
  const int qrow = (is_ctx ? L_ + rowidx * 64 : rowidx * 64) + qc;
  bf16x8 qf[4];
#pragma unroll
  for (int kk = 0; kk < 4; ++kk) qf[kk] = *(const bf16x8*)(U + (size_t)qrow * NIN + head * 64 + 16 * kk + 8 * hh);
  AttnState st; st.o[0] = zero16(); st.o[1] = zero16(); st.m = 0.f; st.l = 0.f;
  const float c1 = 0.125f * LOG2E;
  const int r_start = min(max(rowidx - 4, 0), 248);
  const int cs = min(max(qc - 8, 0), 48);
  const int ntile = is_ctx ? 4 : 12;
  auto tok_of = [&](int t) -> int { const bool w = (!is_ctx) && (t < 8); return w ? (r_start + t) * 64 : L_ + (is_ctx ? t : t - 8) * 64; };
  bf16x8 kreg[8], kregn[8];
  auto ldK = [&](int t, bf16x8 (&kr)[8]) {
    const bf16_t* kb = U + (size_t)tok_of(t) * NIN + 256 + head * 64 + 8 * hh;
#pragma unroll
    for (int ks = 0; ks < 2; ++ks)
#pragma unroll
      for (int kk = 0; kk < 4; ++kk) kr[ks * 4 + kk] = *(const bf16x8*)(kb + (size_t)(32 * ks + r) * NIN + 16 * kk);
  };
  ldK(0, kreg);
#pragma unroll 1
  for (int t = 0; t < ntile; ++t) {
    const bool win = (!is_ctx) && (t < 8);
    const int tok0 = tok_of(t);
    const bf16_t* vb = VNT + (size_t)(head * 64) * T_ + tok0 + 4 * hh;
    u32x2 vreg[32];
#pragma unroll
    for (int dt = 0; dt < 2; ++dt)
#pragma unroll
      for (int ks = 0; ks < 2; ++ks)
#pragma unroll
        for (int step = 0; step < 2; ++step) {
          const bf16_t* b = vb + (size_t)(32 * dt + r) * T_ + 32 * ks + 16 * step;
          vreg[((dt * 2 + ks) * 2 + step) * 2] = *(const u32x2*)b; vreg[((dt * 2 + ks) * 2 + step) * 2 + 1] = *(const u32x2*)(b + 8);
        }
    if (t + 1 < ntile) ldK(t + 1, kregn);
    __builtin_amdgcn_sched_barrier(0);
    auto kf = [&](int ks, int kk) -> bf16x8 { return kreg[ks * 4 + kk]; };
    auto vf = [&](int dt, int ks, int step) -> bf16x8 { return cat44(vreg[((dt * 2 + ks) * 2 + step) * 2], vreg[((dt * 2 + ks) * 2 + step) * 2 + 1]); };
    const float* rp = myrpb + (r_start + t - rowidx + 7) * 31 + 15 - qc;
    auto sf = [&](f32x16 (&s)[2]) {
#pragma unroll
      for (int ks = 0; ks < 2; ++ks)
#pragma unroll
        for (int i = 0; i < 16; ++i) {
          const int kc = 32 * ks + crow(i, hh);
          if (win) {
            const bool ok = (kc >= cs) && (kc < cs + 16);
            s[ks][i] = ok ? (s[ks][i] * c1 + rp[ok ? kc : qc]) : -INFINITY;
          } else s[ks][i] = s[ks][i] * c1;
        }
    };
    attn_tile(st, lane, t == 0, 1.f / c1, qf, kf, vf, sf);
    if (t + 1 < ntile) {
#pragma unroll
      for (int j = 0; j < 8; ++j) kreg[j] = kregn[j];
    }
  }
  attn_store(st, Y + (size_t)qrow * DM + head * 64, hh);
}

DI void ssd_s1_item(int tix, const Params& p, int gc, int h, char* smem) {
  const int tid = tix, lane = tid & 63, wid = tid >> 6, r = lane & 31, hh = lane >> 5;
  const float* DT = (const float*)(p.ws + OFF_DT);
  const float* AC = (const float*)(p.ws + OFF_ACUM);
  float* CDEC = (float*)(p.ws + OFF_CDEC);
  const bf16_t* XBT = (const bf16_t*)(p.ws + OFF_XBT) + (size_t)gc * 768 * 128;
  bf16_t* ST = (bf16_t*)(p.ws + OFF_ST);
  float* sw = (float*)smem;
  __syncthreads();
  {
    const int d = tid >> 7, t = tid & 127, col = d * 8 + h;
    const float tot = AC[(size_t)(gc * 128 + (d ? 0 : 127)) * 16 + col];
    const float ac = AC[(size_t)(gc * 128 + t) * 16 + col], dt = DT[(size_t)(gc * 128 + t) * 16 + col];
    sw[d * 128 + t] = __expf(tot - ac) * dt;
    if (t == 0) CDEC[(d * 8 + h) * NCH + gc] = __expf(tot);
  }
  __syncthreads();
  const int g = h >> 2;
  f32x16 acc[2][2];
  acc[0][0] = zero16(); acc[0][1] = zero16(); acc[1][0] = zero16(); acc[1][1] = zero16();
#pragma unroll
  for (int kk = 0; kk < 8; ++kk) {
    const int kb = 16 * kk + 8 * hh;
    const bf16x8 bfrag = *(const bf16x8*)(XBT + (size_t)(512 + g * 128 + 32 * wid + r) * 128 + kb);
    float wf[8], wb[8];
#pragma unroll
    for (int j = 0; j < 8; ++j) { wf[j] = sw[kb + j]; wb[j] = sw[128 + kb + j]; }
#pragma unroll
    for (int mt = 0; mt < 2; ++mt) {
      const u32x4 xr = *(const u32x4*)(XBT + (size_t)(h * 64 + 32 * mt + r) * 128 + kb);
      u32x4 af, ab;
#pragma unroll
      for (int q = 0; q < 4; ++q) {
        const float lo = bflo(xr[q]), hi = bfhi(xr[q]);
        af[q] = pack2(lo * wf[2 * q], hi * wf[2 * q + 1]);
        ab[q] = pack2(lo * wb[2 * q], hi * wb[2 * q + 1]);
      }
      acc[0][mt] = MFMA32(bfrag, __builtin_bit_cast(bf16x8, af), acc[0][mt]);
      acc[1][mt] = MFMA32(bfrag, __builtin_bit_cast(bf16x8, ab), acc[1][mt]);
    }
  }
#pragma unroll
  for (int d = 0; d < 2; ++d)
#pragma unroll
    for (int mt = 0; mt < 2; ++mt)
#pragma unroll
      for (int q4 = 0; q4 < 4; ++q4) {
        const int pp = 32 * mt + r, n = 32 * wid + 8 * q4 + 4 * hh;
        u32x2 pk = {pack2(acc[d][mt][4 * q4], acc[d][mt][4 * q4 + 1]), pack2(acc[d][mt][4 * q4 + 2], acc[d][mt][4 * q4 + 3])};
        *(u32x2*)(ST + ((size_t)(d * 8 + h) * NCH + gc) * 8192 + pp * 128 + n) = pk;
      }
}

DI void ssd_scan_item(int tix, const Params& p, int it) {
  const int e2 = it * NT + tix;
  const int dh = e2 >> 12, within = e2 & 4095, d = dh >> 3;
  unsigned* ST = (unsigned*)(p.ws + OFF_ST) + (size_t)dh * NCH * 4096 + within;
  const float* CDEC = (const float*)(p.ws + OFF_CDEC) + dh * NCH;
  float r0 = 0.f, r1 = 0.f;
  for (int b = 0; b < 5; ++b) {
    unsigned v[26]; float dec[26];
#pragma unroll
    for (int j = 0; j < 26; ++j) {
      const int i = b * 26 + j;
      const int gc = d ? (129 - i) : (i < 2 ? 128 + i : i - 2);
      v[j] = ST[(size_t)gc * 4096]; dec[j] = CDEC[gc];
    }
#pragma unroll
    for (int j = 0; j < 26; ++j) {
      const int i = b * 26 + j;
      const int gc = d ? (129 - i) : (i < 2 ? 128 + i : i - 2);
      ST[(size_t)gc * 4096] = pack2(r0, r1);
      r0 = dec[j] * r0 + bflo(v[j]); r1 = dec[j] * r1 + bfhi(v[j]);
    }
  }
}

DI void ssd_s3_item(int tix, const Params& p, int layer, int gc, int tq, int g, char* smem, bool do_atomic) {
  const int tid = tix, lane = tid & 63, wid = tid >> 6, r = lane & 31, hh = lane >> 5;
  const float* DT = (const float*)(p.ws + OFF_DT);
  const float* AC = (const float*)(p.ws + OFF_ACUM);
  const bf16_t* XBT = (const bf16_t*)(p.ws + OFF_XBT) + (size_t)gc * 768 * 128;
  const bf16_t* BC = (const bf16_t*)(p.ws + OFF_BC) + (size_t)gc * 128 * 512;
  const bf16_t* ST = (const bf16_t*)(p.ws + OFF_ST);
  const bf16_t* U = (const bf16_t*)(p.ws + OFF_U);
  bf16_t* Y = (bf16_t*)(p.ws + OFF_A1);
  float* SSQ = (float*)(p.ws + OFF_SSQ);
  float* sAc = (float*)smem;
  float* sDt = sAc + 16 * 128;
  const int h = 4 * g + wid;
  const int tl = 32 * tq + r;
  const size_t trow = (size_t)gc * 128 + tl;
  f32x4 fa[2], fd[2];
#pragma unroll
  for (int i = 0; i < 2; ++i) { fa[i] = *(const f32x4*)(AC + (size_t)(gc * 128) * 16 + 4 * (tid + NT * i)); fd[i] = *(const f32x4*)(DT + (size_t)(gc * 128) * 16 + 4 * (tid + NT * i)); }
  bf16x8 cf[8];
#pragma unroll
  for (int kk = 0; kk < 8; ++kk) cf[kk] = *(const bf16x8*)(BC + (size_t)tl * 512 + 256 + g * 128 + 16 * kk + 8 * hh);
  bf16x8 bfc[8], bfn[8]; u32x2 xac[8], xan[8];
  auto ldB = [&](int stl, bf16x8 (&bf)[8], u32x2 (&xa)[8]) {
#pragma unroll
    for (int kk = 0; kk < 8; ++kk) bf[kk] = *(const bf16x8*)(BC + (size_t)(32 * stl + r) * 512 + g * 128 + 16 * kk + 8 * hh);
    const bf16_t* xb0 = XBT + (size_t)(h * 64 + r) * 128 + 32 * stl + 4 * hh;
#pragma unroll
    for (int q = 0; q < 4; ++q) { xa[q] = *(const u32x2*)(xb0 + 8 * q); xa[4 + q] = *(const u32x2*)(xb0 + 32 * 128 + 8 * q); }
  };
  ldB(0, bfc, xac);
  __syncthreads();
#pragma unroll
  for (int i = 0; i < 2; ++i) { *(f32x4*)(sAc + 4 * (tid + NT * i)) = fa[i]; *(f32x4*)(sDt + 4 * (tid + NT * i)) = fd[i]; }
  __syncthreads();
  const float acf_t = sAc[tl * 16 + h], acb_t = sAc[tl * 16 + 8 + h];
  const float Dh = p.ssd_d[layer * 8 + h];
  f32x16 y[2]; y[0] = zero16(); y[1] = zero16();
  u32x2 zz[8];
#pragma unroll
  for (int stl = 0; stl < 4; ++stl) {
    if (stl < 3) ldB(stl + 1, bfn, xan);
    else {
#pragma unroll
      for (int q = 0; q < 8; ++q) zz[q] = *(const u32x2*)(U + trow * NIN + 768 + h * 64 + 32 * (q >> 2) + 8 * (q & 3) + 4 * hh);
    }
    __builtin_amdgcn_sched_barrier(0);
    f32x16 gt = zero16();
#pragma unroll
    for (int kk = 0; kk < 8; ++kk) gt = MFMA32(bfc[kk], cf[kk], gt);
    f32x16 pt;
#pragma unroll
    for (int reg = 0; reg < 16; ++reg) {
      const int s = 32 * stl + crow(reg, hh);
      float f = 0.f;
      if (s <= tl) f += __expf(acf_t - sAc[s * 16 + h]) * sDt[s * 16 + h];
      if (s >= tl) f += __expf(acb_t - sAc[s * 16 + 8 + h]) * sDt[s * 16 + 8 + h];
      pt[reg] = gt[reg] * f + (s == tl ? Dh : 0.f);
    }
    const bf16x8 p0 = pack8<0>(pt), p1 = pack8<1>(pt);
    y[0] = MFMA32(cat44(xac[0], xac[1]), p0, y[0]); y[0] = MFMA32(cat44(xac[2], xac[3]), p1, y[0]);
    y[1] = MFMA32(cat44(xac[4], xac[5]), p0, y[1]); y[1] = MFMA32(cat44(xac[6], xac[7]), p1, y[1]);
    if (stl < 3) {
#pragma unroll
      for (int kk = 0; kk < 8; ++kk) bfc[kk] = bfn[kk];
#pragma unroll
      for (int q = 0; q < 8; ++q) xac[q] = xan[q];
    }
  }
#pragma unroll
  for (int d = 0; d < 2; ++d) {
    const bf16_t* Hb = ST + ((size_t)(d * 8 + h) * NCH + gc) * 8192;
    bf16x8 hf[2][8];
#pragma unroll
    for (int mt = 0; mt < 2; ++mt)
#pragma unroll
      for (int kk = 0; kk < 8; ++kk) hf[mt][kk] = *(const bf16x8*)(Hb + (size_t)(32 * mt + r) * 128 + 16 * kk + 8 * hh);
    f32x16 a2[2]; a2[0] = zero16(); a2[1] = zero16();
#pragma unroll
    for (int kk = 0; kk < 8; ++kk) { a2[0] = MFMA32(hf[0][kk], cf[kk], a2[0]); a2[1] = MFMA32(hf[1][kk], cf[kk], a2[1]); }
    const float e = __expf(d ? acb_t : acf_t);
#pragma unroll
    for (int mt = 0; mt < 2; ++mt)
#pragma unroll
      for (int reg = 0; reg < 16; ++reg) y[mt][reg] += e * a2[mt][reg];
  }
  float ssq = 0.f;
#pragma unroll
  for (int mt = 0; mt < 2; ++mt)
#pragma unroll
    for (int q4 = 0; q4 < 4; ++q4) {
      const int p0 = 32 * mt + 8 * q4 + 4 * hh;
      const u32x2 z2 = zz[4 * mt + q4];
      const f32x4 nw = *(const f32x4*)(p.ssd_norm_w + layer * 512 + h * 64 + p0);
      float zv[4] = {bflo(z2[0]), bfhi(z2[0]), bflo(z2[1]), bfhi(z2[1])};
      float o[4];
#pragma unroll
      for (int j = 0; j < 4; ++j) {
        const float yy = y[mt][4 * q4 + j] * siluf(zv[j]);
        ssq += yy * yy;
        o[j] = yy * nw[j];
      }
      u32x2 pk = {pack2(o[0], o[1]), pack2(o[2], o[3])};
      *(u32x2*)(Y + trow * DM + 256 + h * 64 + p0) = pk;
    }
  ssq += shx(ssq, 32, lane);
  if (hh == 0 && do_atomic) atomicAdd(SSQ + trow, ssq);
}

DI void tile_swz(int it, int nM, int nN, int& pm, int& pn) {
  constexpr int NX = 8, WGM = 8;
  const int total = nM * nN, q = total / NX, rr = total % NX, xcd = it % NX, off = it / NX;
  const int wgid = (xcd < rr ? xcd * (q + 1) : rr * (q + 1) + (xcd - rr) * q) + off;
  const int nig = WGM * nN, gid = wgid / nig, fm = gid * WGM, gsz = min(nM - fm, WGM);
  pm = fm + (wgid % nig) % gsz; pn = (wgid % nig) / gsz;
}

enum { PH_INIT = 0, PH_NORM1, PH_INPROJ, PH_PREP, PH_MIX1, PH_SCAN, PH_S3, PH_OUTPROJ, PH_NORM2, PH_FFN1, PH_FFN2, PH_FINAL };

DI void run_phase(const Params& p, int ph, int layer, int bid, int nb, char* smem, bool last_rep = true) {
  int tix = threadIdx.x;
  asm volatile("" : "+v"(tix));
  const bool ctx_out = layer < 1;
  const float* MOD = (const float*)(p.ws + OFF_MOD);
  switch (ph) {
    case PH_INIT: {
      const int total = 192 + 16 + 64 + WC_TOTAL;
      for (int it = bid; it < total; it += nb) {
        int tx = tix; asm volatile("" : "+v"(tx));
        if (it < 192) mod_item(tx, p, it, smem);
        else if (it < 208) rope_item(tx, p, it - 192);
        else if (it < 272) {
          const f32x4* src = (const f32x4*)(p.ctx + (size_t)(it - 208) * 4096); f32x4* dst = (f32x4*)((float*)(p.ws + OFF_XC) + (size_t)(it - 208) * 4096);
#pragma unroll
          for (int i = 0; i < 4; ++i) dst[tx + NT * i] = src[tx + NT * i];
        }
        else wconv_item(tx, p, 0, it - 272, smem);
      }
    } break;
    case PH_NORM1: {
      const int total = T_ / 8 + (layer > 0 ? WC_TOTAL : 0);
      for (int it = bid; it < total; it += nb) {
        int tx = tix; asm volatile("" : "+v"(tx));
        if (it < T_ / 8) norm_item(tx, p, layer, 0, it);
        else wconv_item(tx, p, layer, it - T_ / 8, smem);
      }
    } break;
    case PH_INPROJ: {
      Epi256InProj epi{(bf16_t*)(p.ws + OFF_U), (float*)(p.ws + OFF_DTRAW)};
      const int total = 65 * 23;
      for (int it = bid; it < total; it += nb) {
        int tx = tix; asm volatile("" : "+v"(tx));
#ifdef PROBE_NOLOAD
        if (!last_rep) gemm_tile256<false, true>(tx, nullptr, (const bf16_t*)(p.ws + OFF_A1), DM, (const bf16_t*)(p.ws + OFF_WIN), DM, DM, (it / 23) * 256, (it % 23) * 128, smem, epi); else
#endif
        { int pm, pn; tile_swz(it, 65, 23, pm, pn);
          gemm_tile256<false>(tx, nullptr, (const bf16_t*)(p.ws + OFF_A1), DM, (const bf16_t*)(p.ws + OFF_WIN), DM, DM, pm * 256, pn * 128, smem, epi); }
      }
    } break;
    case PH_PREP: {
      const int n0 = 260 * 4, n1 = n0 + NCH, n2 = n1 + 780, n3 = n2 + 260 + 130;
      for (int it = bid; it < n3; it += nb) {
        int tx = tix; asm volatile("" : "+v"(tx));
        if (it < n0) conv_item(tx, p, layer, it);
        else if (it < n1) dt_item(tx, p, layer, it - n0, smem);
        else if (it < n2) qk_item(tx, p, layer, it - n1);
        else vtr_item(tx, p, it - n2);
      }
    } break;
    case PH_MIX1: {
      const int nctx = ctx_out ? 8 : 0;
      const int n0 = 512, n1 = n0 + nctx, n2 = n1 + 512, n3 = n2 + nctx, n4 = n3 + NCH * 8;
      const int nround = (n4 + nb - 1) / nb;
      for (int kk = 0; kk < nround; ++kk) {
        const int k = (bid >= (nb >> 1)) ? ((kk + 1 == nround) ? 0 : kk + 1) : kk;
        const int it = bid + k * nb;
        if (it >= n4) continue;
        int tx = tix; asm volatile("" : "+v"(tx));
        if (it < n0) gqa_item(tx, p, ((it & 3) + 4 * (it >> 3)) * 64, (it >> 2) & 1, 0, 260, smem);
        else if (it < n1) { const int j = it - n0; gqa_item(tx, p, L_ + (j >> 1) * 64, j & 1, 256, 260, smem); }
        else if (it < n2) { const int j = it - n1; na_item(tx, p, layer, j >> 1, j & 1, false, smem); }
        else if (it < n3) { const int j = it - n2; na_item(tx, p, layer, j >> 1, j & 1, true, smem); }
        else { const int j = it - n3; ssd_s1_item(tx, p, j >> 3, j & 7, smem); }
      }
    } break;
    case PH_SCAN: {
      for (int it = bid; it < 256; it += nb) ssd_scan_item(tix, p, it);
    } break;
    case PH_S3: {
      const int total = (ctx_out ? NCH : 128) * 8;
      for (int it = bid; it < total; it += nb) {
        int tx = tix; asm volatile("" : "+v"(tx));
        ssd_s3_item(tx, p, layer, it >> 3, (it >> 1) & 3, it & 1, smem, last_rep);
      }
    } break;
    case PH_OUTPROJ: {
      EpiResid epi{layer == 0 ? p.x : p.out, (const float*)(p.ws + OFF_XC), p.out, (float*)(p.ws + OFF_XC),
                   MOD + (layer * 2 + 0) * 6144 + 2 * DM, MOD + (layer * 2 + 1) * 6144 + 2 * DM};
      EpiCtxAtomic epc{(float*)(p.ws + OFF_XC), MOD + (layer * 2 + 1) * 6144 + 2 * DM};
      const int nsplit = ctx_out ? 64 : 0;
      const int total = nsplit + 128 * 8;
      for (int it = bid; it < total; it += nb) {
        int tx = tix; asm volatile("" : "+v"(tx));
        if (it < nsplit) { const int tile = it >> 2, kq = it & 3;
          gemm_tile<true>(tx, (const float*)(p.ws + OFF_SSQ), (const bf16_t*)(p.ws + OFF_A1), DM, (const bf16_t*)(p.ws + OFF_WOUT), DM, DM / 4, L_ + (tile >> 3) * 128, (tile & 7) * 128, smem, epc, kq * (DM / 4));
        } else { const int j = it - nsplit; int pm, pn; tile_swz(j, 128, 8, pm, pn);
          gemm_tile<true>(tx, (const float*)(p.ws + OFF_SSQ), (const bf16_t*)(p.ws + OFF_A1), DM, (const bf16_t*)(p.ws + OFF_WOUT), DM, DM, pm * 128, pn * 128, smem, epi);
        }
      }
    } break;
    case PH_NORM2: {
      const int total = (ctx_out ? T_ : L_) / 8;
      for (int it = bid; it < total; it += nb) norm_item(tix, p, layer, 1, it);
    } break;
    case PH_FFN1: {
      Epi256SwiGLU epi{(bf16_t*)(p.ws + OFF_U)};
      const int total = (ctx_out ? 65 : 64) * 44;
      for (int it = bid; it < total; it += nb) {
        int tx = tix; asm volatile("" : "+v"(tx));
#ifdef PROBE_NOLOAD
        if (!last_rep) gemm_tile256<false, true>(tx, nullptr, (const bf16_t*)(p.ws + OFF_A1), DM, (const bf16_t*)(p.ws + OFF_WGU), DM, DM, (it / 44) * 256, (it % 44) * 128, smem, epi); else
#endif
        { int pm, pn; tile_swz(it, ctx_out ? 65 : 64, 44, pm, pn);
          gemm_tile256<false>(tx, nullptr, (const bf16_t*)(p.ws + OFF_A1), DM, (const bf16_t*)(p.ws + OFF_WGU), DM, DM, pm * 256, pn * 128, smem, epi); }
      }
    } break;
    case PH_FFN2: {
      Epi256Resid epi{p.out, p.out, MOD + (layer * 2 + 0) * 6144 + 5 * DM};
      Epi256CtxAtomic epc{(float*)(p.ws + OFF_XC), MOD + (layer * 2 + 1) * 6144 + 5 * DM};
      const int nsplit = ctx_out ? 32 : 0;
      const int total = nsplit + 64 * 8;
      for (int it = bid; it < total; it += nb) {
        int tx = tix; asm volatile("" : "+v"(tx));
        if (it < nsplit) { const int tile = it >> 2, kq = it & 3;
          gemm_tile256<false>(tx, nullptr, (const bf16_t*)(p.ws + OFF_U), FH, (const bf16_t*)(p.ws + OFF_WD), FH, FH / 4, L_, tile * 128, smem, epc, kq * (FH / 4));
        } else { const int j = it - nsplit; int pm, pn; tile_swz(j, 64, 8, pm, pn);
          gemm_tile256<false>(tx, nullptr, (const bf16_t*)(p.ws + OFF_U), FH, (const bf16_t*)(p.ws + OFF_WD), FH, FH, pm * 256, pn * 128, smem, epi);
        }
      }
    } break;
    case PH_FINAL: {
      for (int it = bid; it < L_ / 8; it += nb) norm_item(tix, p, 1, 2, it);
    } break;
  }
}

#define XB_TMO      128
#define XB_XCNT(j)  (256  + 64 * (j))
#define XB_XSUB(j)  (1280 + 64 * (j))
#define XB_XGEN(j)  (2304 + 64 * (j))
#define XB_TOP      3328
#define XB_TOPGEN   3392
#define XB_SPIN_CAP (1u << 22)
DI unsigned xb_ld(unsigned* p) { return __hip_atomic_load(p, __ATOMIC_RELAXED, __HIP_MEMORY_SCOPE_AGENT); }
DI unsigned xb_add(unsigned* p, unsigned v) { return __hip_atomic_fetch_add(p, v, __ATOMIC_RELAXED, __HIP_MEMORY_SCOPE_AGENT); }
DI unsigned xb_xcc_id() { return (unsigned)__builtin_amdgcn_s_getreg((3 << 11) | 20) & 0xFu; }
#define XB_SPIN(cond, bar) do { unsigned _sp = 0; while (cond) { __builtin_amdgcn_s_sleep(1); \
    if ((++_sp & 255u) == 0u) { if (xb_ld(&(bar)[XB_TMO])) break; if (_sp > XB_SPIN_CAP) { atomicAdd(&(bar)[XB_TMO], 1u); break; } } } } while (0)
DI void xb_complete(unsigned* bar, unsigned x, unsigned G, unsigned& nloc, unsigned& nx) {
  unsigned sum, cnt, mine, sp = 0u;
  for (;;) {
    sum = 0u; cnt = 0u; mine = 0u;
#pragma unroll
    for (unsigned j = 0; j < 16; ++j) { const unsigned c = xb_ld(&bar[XB_XCNT(j)]); sum += c; cnt += (c > 0u) ? 1u : 0u; mine = (j == x) ? c : mine; }
    if (sum == G) break;
    __builtin_amdgcn_s_sleep(1);
    if ((++sp & 255u) == 0u) { if (xb_ld(&bar[XB_TMO])) break; if (sp > XB_SPIN_CAP) { atomicAdd(&bar[XB_TMO], 1u); break; } }
  }
  nloc = mine > 0u ? mine : 1u; nx = cnt > 0u ? cnt : 1u;
}
DI void grid_barrier(unsigned* bar, volatile unsigned* st, unsigned x, unsigned G) {
  asm volatile("s_waitcnt vmcnt(0)" ::: "memory");
  __syncthreads();
  if (threadIdx.x == 0) {
    __builtin_amdgcn_s_waitcnt(0);
    unsigned nloc = st[0], nx = st[1];
    if (nloc == 0u) { xb_complete(bar, x, G, nloc, nx); st[0] = nloc; st[1] = nx; }
    const unsigned old = xb_add(&bar[XB_XSUB(x)], 1u);
    const unsigned gen = old / nloc;
    if (old + 1u == (gen + 1u) * nloc) {
      __builtin_amdgcn_fence(__ATOMIC_RELEASE, "agent");
      asm volatile("s_waitcnt vmcnt(0)" ::: "memory");
      const unsigned og = xb_add(&bar[XB_TOP], 1u);
      const unsigned tg = og / nx;
      if (og + 1u == (tg + 1u) * nx) xb_add(&bar[XB_TOPGEN], 1u);
      else XB_SPIN(xb_ld(&bar[XB_TOPGEN]) == tg, bar);
      __builtin_amdgcn_fence(__ATOMIC_ACQUIRE, "agent");
      xb_add(&bar[XB_XGEN(x)], 1u);
      asm volatile("s_waitcnt vmcnt(0)" ::: "memory");
    } else {
      XB_SPIN(xb_ld(&bar[XB_XGEN(x)]) == gen, bar);
      __builtin_amdgcn_fence(__ATOMIC_ACQUIRE, "agent");
      asm volatile("s_waitcnt vmcnt(0)" ::: "memory");
    }
  }
  __syncthreads();
}

#if MULTI_LAUNCH
extern __shared__ __attribute__((aligned(16))) char smem[];
template <int PH> __global__ void __launch_bounds__(NT, 2) phase_kernel(Params p, int layer) {
  run_phase(p, PH, layer, blockIdx.x, gridDim.x, smem);
}
template <int PH> static void launch_phase(const Params& p, int layer, hipStream_t stream) {
  (void)hipFuncSetAttribute((const void*)phase_kernel<PH>, hipFuncAttributeMaxDynamicSharedMemorySize, SMEM_BYTES);
  phase_kernel<PH><<<1024, NT, SMEM_BYTES, stream>>>(p, layer);
}
#else
extern __shared__ __attribute__((aligned(16))) char smem[];
__global__ void __launch_bounds__(NT, 2) mega_kernel(Params p) {
  cg::grid_group grid = cg::this_grid();
  const int bid = blockIdx.x, nb = gridDim.x;
  unsigned* bar = (unsigned*)(p.ws + OFF_BAR);
  volatile unsigned* st = (volatile unsigned*)(smem + SMEM_BYTES);
  if (threadIdx.x == 0) { st[0] = 0u; st[1] = 0u; }
  const unsigned xcc = xb_xcc_id();
  if (threadIdx.x == 0) (void)xb_add(&bar[XB_XCNT(xcc)], 1u);
  if (p.ws == nullptr) grid.sync();
  run_phase(p, PH_INIT, 0, bid, nb, smem);
  grid_barrier(bar, st, xcc, (unsigned)nb);
  for (int layer = 0; layer < 2; ++layer) {
    for (int ph = PH_NORM1; ph <= PH_FFN2; ++ph) {
#ifdef DUP_MASK
      const int reps = 1 + ((DUP_MASK >> ph) & 1);
#else
      const int reps = 1;
#endif
#pragma unroll 1
      for (int rep = 0; rep < reps; ++rep) {
        run_phase(p, ph, layer, bid, nb, smem, rep == reps - 1);
        grid_barrier(bar, st, xcc, (unsigned)nb);
      }
    }
  }
#ifdef EXTRA_SYNCS
#pragma unroll 1
  for (int i = 0; i < EXTRA_SYNCS; ++i) grid_barrier(bar, st, xcc, (unsigned)nb);
#endif
  run_phase(p, PH_FINAL, 1, bid, nb, smem);
}
#endif

extern "C" void kernel_launch(void* const* d_in, const int* in_sizes, int n_in, void* d_out, int out_size, void* d_ws, size_t ws_size,
                              hipStream_t stream) {
  Params p{};
  const float** pf = (const float**)&p;
  for (int i = 0; i < 23; ++i) pf[i] = (const float*)d_in[i];
  p.out = (float*)d_out;
  p.ws = (char*)d_ws;
#if MULTI_LAUNCH
  launch_phase<PH_INIT>(p, 0, stream);
  for (int layer = 0; layer < 2; ++layer) {
    launch_phase<PH_NORM1>(p, layer, stream); launch_phase<PH_INPROJ>(p, layer, stream); launch_phase<PH_PREP>(p, layer, stream);
    launch_phase<PH_MIX1>(p, layer, stream); launch_phase<PH_SCAN>(p, layer, stream); launch_phase<PH_S3>(p, layer, stream);
    launch_phase<PH_OUTPROJ>(p, layer, stream); launch_phase<PH_NORM2>(p, layer, stream); launch_phase<PH_FFN1>(p, layer, stream);
    launch_phase<PH_FFN2>(p, layer, stream);
  }
  launch_phase<PH_FINAL>(p, 1, stream);
#else
  static int grid_blocks = 0;
  if (!grid_blocks) {
    int dev = 0, cus = 0, per_cu = 0;
    (void)hipGetDevice(&dev);
    (void)hipDeviceGetAttribute(&cus, hipDeviceAttributeMultiprocessorCount, dev);
    (void)hipFuncSetAttribute((const void*)mega_kernel, hipFuncAttributeMaxDynamicSharedMemorySize, SMEM_BYTES + 16);
    (void)hipOccupancyMaxActiveBlocksPerMultiprocessor(&per_cu, mega_kernel, NT, SMEM_BYTES + 16);
    if (per_cu > 2) per_cu = 2;
    grid_blocks = cus * per_cu;
  }
  (void)hipMemsetAsync((char*)d_ws + OFF_BAR, 0, 64 * 256, stream);
  void* args[] = {&p};
  hipError_t e = hipLaunchCooperativeKernel((void*)mega_kernel, dim3(grid_blocks), dim3(NT), args, SMEM_BYTES + 16, stream);
  if (e != hipSuccess) fprintf(stderr, "cooperative launch failed: %s (grid %d)\n", hipGetErrorString(e), grid_blocks);
#endif
}
```

```cpp
#include <hip/hip_runtime.h>
#include <hip/hip_cooperative_groups.h>
#include <cstdio>
#include <cstdint>
namespace cg = cooperative_groups;

#ifndef MULTI_LAUNCH
#define MULTI_LAUNCH 0
#endif

#define DI __device__ __forceinline__
typedef unsigned short bf16_t;
typedef short bf16x8 __attribute__((ext_vector_type(8)));
typedef short bf16x4 __attribute__((ext_vector_type(4)));
typedef float f32x16 __attribute__((ext_vector_type(16)));
typedef float f32x4 __attribute__((ext_vector_type(4)));
typedef float f32x2 __attribute__((ext_vector_type(2)));
typedef unsigned u32x4 __attribute__((ext_vector_type(4)));
typedef unsigned u32x2 __attribute__((ext_vector_type(2)));
typedef __bf16 bf16v2 __attribute__((ext_vector_type(2)));

#define MFMA32(a, b, c) __builtin_amdgcn_mfma_f32_32x32x16_bf16((a), (b), (c), 0, 0, 0)
#define MFMA16(a, b, c) __builtin_amdgcn_mfma_f32_16x16x32_bf16((a), (b), (c), 0, 0, 0)

constexpr int L_ = 16384, LC_ = 256, T_ = 16640, DM = 1024, NIN = 2832, NINP = 2944, FH = 2816, NCH = 130;
constexpr int NT = 256;
constexpr float EPSF = 1e-6f;
constexpr float LOG2E = 1.4426950408889634f;
constexpr int SMEM_BYTES = 73728;

constexpr size_t al256(size_t x) { return (x + 255) & ~(size_t)255; }
constexpr size_t OFF_WIN = 0;
constexpr size_t OFF_WOUT = OFF_WIN + al256((size_t)NINP * DM * 2);
constexpr size_t OFF_WGU = OFF_WOUT + al256((size_t)DM * DM * 2);
constexpr size_t OFF_WD = OFF_WGU + al256((size_t)2 * FH * DM * 2);
constexpr size_t OFF_MOD = OFF_WD + al256((size_t)DM * FH * 2);
constexpr size_t OFF_ROPE = OFF_MOD + al256((size_t)2 * 2 * 6144 * 4);
constexpr size_t OFF_XC = OFF_ROPE + al256((size_t)256 * 16 * 8);
constexpr size_t OFF_A1 = OFF_XC + al256((size_t)LC_ * DM * 4);
constexpr size_t OFF_U = OFF_A1 + al256((size_t)T_ * DM * 2);
constexpr size_t OFF_DTRAW = OFF_U + al256((size_t)T_ * NIN * 2);
constexpr size_t OFF_DT = OFF_DTRAW + al256((size_t)T_ * 16 * 4);
constexpr size_t OFF_ACUM = OFF_DT + al256((size_t)T_ * 16 * 4);
constexpr size_t OFF_XBT = OFF_ACUM + al256((size_t)T_ * 16 * 4);
constexpr size_t OFF_BC = OFF_XBT + al256((size_t)NCH * 768 * 128 * 2);
constexpr size_t OFF_QG = OFF_BC + al256((size_t)T_ * 512 * 2);
constexpr size_t OFF_KG = OFF_QG + al256((size_t)T_ * 256 * 2);
constexpr size_t OFF_VGT = OFF_KG + al256((size_t)T_ * 128 * 2);
constexpr size_t OFF_VNT = OFF_VGT + al256((size_t)T_ * 128 * 2);
constexpr size_t OFF_ST = OFF_VNT + al256((size_t)T_ * 256 * 2);
constexpr size_t OFF_CDEC = OFF_ST + al256((size_t)16 * NCH * 8192 * 2);
constexpr size_t OFF_SSQ = OFF_CDEC + al256((size_t)16 * NCH * 4);
constexpr size_t OFF_BAR = OFF_SSQ + al256((size_t)T_ * 4);
constexpr size_t WS_TOTAL = OFF_BAR + 64 * 256;
static_assert(WS_TOTAL <= (size_t)256 * 1024 * 1024, "workspace too large");

struct Params {
  const float *x, *c, *ctx, *c_ctx, *mod_w, *mod_b, *norm_attn_w, *norm_ffn_w, *w_in, *na_rpb, *conv_w, *conv_b, *dt_bias, *a_log,
      *ssd_d, *ssd_norm_w, *q_norm_w, *k_norm_w, *w_out, *w_gate, *w_up, *w_down, *final_norm_w;
  float* out;
  char* ws;
};

DI unsigned pack2(float lo, float hi) { f32x2 v = {lo, hi}; return __builtin_bit_cast(unsigned, __builtin_convertvector(v, bf16v2)); }
DI bf16_t f2bf(float x) { return (bf16_t)(pack2(x, 0.f) & 0xffffu); }
DI float bf2f(bf16_t v) { return __uint_as_float(((unsigned)v) << 16); }
DI float bflo(unsigned u) { return __uint_as_float(u << 16); }
DI float bfhi(unsigned u) { return __uint_as_float(u & 0xffff0000u); }
DI int crow(int reg, int hh) { return (reg & 3) + 8 * (reg >> 2) + 4 * hh; }
DI float siluf(float x) { return x * __builtin_amdgcn_rcpf(1.f + __expf(-x)); }
DI f32x16 zero16() { f32x16 z; for (int i = 0; i < 16; ++i) z[i] = 0.f; return z; }
template <int S> DI bf16x8 pack8(const f32x16& x) {
  u32x4 p;
  p[0] = pack2(x[8 * S + 0], x[8 * S + 1]); p[1] = pack2(x[8 * S + 2], x[8 * S + 3]);
  p[2] = pack2(x[8 * S + 4], x[8 * S + 5]); p[3] = pack2(x[8 * S + 6], x[8 * S + 7]);
  return __builtin_bit_cast(bf16x8, p);
}
DI bf16x8 cat44(u32x2 lo, u32x2 hi) { u32x4 p = {lo[0], lo[1], hi[0], hi[1]}; return __builtin_bit_cast(bf16x8, p); }
DI float shx(float v, int mask, int lane) { return __int_as_float(__builtin_amdgcn_ds_bpermute((lane ^ mask) << 2, __float_as_int(v))); }
DI float wave_sum(float v, int lane) {
#pragma unroll
  for (int o = 32; o > 0; o >>= 1) v += shx(v, o, lane);
  return v;
}

DI void mod_item(int tix, const Params& p, int it, char* smem) {
  const int tid = tix, layer = it / 96, cg64 = it % 96, col = tid & 63, kq = tid >> 6;
  const float* W = p.mod_w + (size_t)layer * DM * 6144 + cg64 * 64 + col;
  float* sc = (float*)smem;
  float* red = sc + 2048;
  __syncthreads();
  for (int i = tid; i < 1024; i += NT) { sc[i] = siluf(p.c[i]); sc[1024 + i] = siluf(p.c_ctx[i]); }
  __syncthreads();
  float a0 = 0.f, a1 = 0.f;
#pragma unroll 1
  for (int k0 = kq * 256; k0 < kq * 256 + 256; k0 += 16) {
    float w[16];
#pragma unroll
    for (int j = 0; j < 16; ++j) w[j] = W[(size_t)(k0 + j) * 6144];
#pragma unroll
    for (int j = 0; j < 16; ++j) { a0 += sc[k0 + j] * w[j]; a1 += sc[1024 + k0 + j] * w[j]; }
  }
  red[(0 * 4 + kq) * 64 + col] = a0; red[(1 * 4 + kq) * 64 + col] = a1;
  __syncthreads();
  if (tid < 128) {
    const int src = tid >> 6;
    float s = red[(src * 4 + 0) * 64 + col] + red[(src * 4 + 1) * 64 + col] + red[(src * 4 + 2) * 64 + col] + red[(src * 4 + 3) * 64 + col];
    s += p.mod_b[layer * 6144 + cg64 * 64 + col];
    float* MOD = (float*)(p.ws + OFF_MOD);
    MOD[(layer * 2 + src) * 6144 + cg64 * 64 + col] = s;
  }
}
DI void rope_item(int tix, const Params& p, int it) {
  const int e = it * NT + tix;
  const int pos = e >> 4, j = e & 15;
  const double freq = exp2(-(double)j * (13.287712379549449 / 16.0));
  double rv = (double)pos * freq * 0.15915494309189535;
  rv -= floor(rv);
  const float fr = (float)rv;
  f32x2* R = (f32x2*)(p.ws + OFF_ROPE);
  f32x2 cs = {__builtin_amdgcn_cosf(fr), __builtin_amdgcn_sinf(fr)};
  R[e] = cs;
}

DI void wconv_tile(int tix, const float* __restrict__ src0, const float* __restrict__ src1, int ldsrc, int ncols_valid, bf16_t* __restrict__ dst, int K,
                   int nt, int kt, int mode, char* smem) {
  float* tile = (float*)smem;
  const int tid = tix, cn = tid & 63, rq = tid >> 6;
  __syncthreads();
  for (int i = 0; i < 16; ++i) {
    const int k = i * 4 + rq;
    float v;
    if (mode == 0) { const int n = nt * 64 + cn; v = (n < ncols_valid) ? src0[(size_t)(kt * 64 + k) * ldsrc + n] : 0.f; }
    else { const int unit = nt * 32 + (cn & 31); v = ((cn >> 5) ? src1 : src0)[(size_t)(kt * 64 + k) * ldsrc + unit]; }
    tile[k * 65 + cn] = v;
  }
  __syncthreads();
  for (int i = 0; i < 16; ++i) {
    const int n = i * 4 + rq, k = cn;
    dst[(size_t)(nt * 64 + n) * K + kt * 64 + k] = f2bf(tile[k * 65 + n]);
  }
}
constexpr int WC_IN = 46 * 16, WC_OUT = 16 * 16, WC_GU = 88 * 16, WC_D = 16 * 44, WC_TOTAL = WC_IN + WC_OUT + WC_GU + WC_D;
DI void wconv_item(int tix, const Params& p, int layer, int it, char* smem) {
  if (it < WC_IN) { wconv_tile(tix, p.w_in + (size_t)layer * DM * NIN, nullptr, NIN, NIN, (bf16_t*)(p.ws + OFF_WIN), DM, it / 16, it % 16, 0, smem); return; }
  it -= WC_IN;
  if (it < WC_OUT) { wconv_tile(tix, p.w_out + (size_t)layer * DM * DM, nullptr, DM, DM, (bf16_t*)(p.ws + OFF_WOUT), DM, it / 16, it % 16, 0, smem); return; }
  it -= WC_OUT;
  if (it < WC_GU) { wconv_tile(tix, p.w_gate + (size_t)layer * DM * FH, p.w_up + (size_t)layer * DM * FH, FH, FH, (bf16_t*)(p.ws + OFF_WGU), DM, it / 16, it % 16, 1, smem); return; }
  it -= WC_GU;
  wconv_tile(tix, p.w_down + (size_t)layer * FH * DM, nullptr, DM, DM, (bf16_t*)(p.ws + OFF_WD), FH, it / 44, it % 44, 0, smem);
}

DI void norm_item(int tix, const Params& p, int layer, int which, int it) {
  const int lane = tix & 63, wid = tix >> 6;
  const float* MOD = (const float*)(p.ws + OFF_MOD);
  const float* XC = (const float*)(p.ws + OFF_XC);
  bf16_t* A1 = (bf16_t*)(p.ws + OFF_A1);
  f32x4 v[2][4];
#pragma unroll
  for (int rr = 0; rr < 2; ++rr) {
    const int row = it * 8 + wid * 2 + rr;
    const float* src;
    if (row < L_) src = ((layer == 0 && which == 0) ? p.x : p.out) + (size_t)row * DM;
    else src = ((layer == 0 && which == 0) ? p.ctx : XC) + (size_t)(row - L_) * DM;
#pragma unroll
    for (int i = 0; i < 4; ++i) v[rr][i] = *(const f32x4*)(src + i * 256 + lane * 4);
  }
#pragma unroll
  for (int rr = 0; rr < 2; ++rr) {
    const int row = it * 8 + wid * 2 + rr;
    float ss = 0.f;
#pragma unroll
    for (int i = 0; i < 4; ++i) ss += v[rr][i][0] * v[rr][i][0] + v[rr][i][1] * v[rr][i][1] + v[rr][i][2] * v[rr][i][2] + v[rr][i][3] * v[rr][i][3];
    ss = wave_sum(ss, lane);
    const float rstd = rsqrtf(ss * (1.f / DM) + EPSF);
    if (which == 2) {
      float* dst = p.out + (size_t)row * DM;
#pragma unroll
      for (int i = 0; i < 4; ++i) {
        const f32x4 w = *(const f32x4*)(p.final_norm_w + i * 256 + lane * 4);
        f32x4 o; for (int j = 0; j < 4; ++j) o[j] = v[rr][i][j] * rstd * w[j];
        *(f32x4*)(dst + i * 256 + lane * 4) = o;
      }
    } else {
      const float* nw = (which == 0 ? p.norm_attn_w : p.norm_ffn_w) + layer * DM;
      const float* md = MOD + (layer * 2 + (row >= L_ ? 1 : 0)) * 6144 + (which == 0 ? 0 : 3 * DM);
#pragma unroll
      for (int i = 0; i < 4; ++i) {
        const int c = i * 256 + lane * 4;
        const f32x4 w = *(const f32x4*)(nw + c), sh = *(const f32x4*)(md + c), sc = *(const f32x4*)(md + DM + c);
        float o[4]; for (int j = 0; j < 4; ++j) o[j] = v[rr][i][j] * rstd * w[j] * (1.f + sc[j]) + sh[j];
        u32x2 pk = {pack2(o[0], o[1]), pack2(o[2], o[3])};
        *(u32x2*)(A1 + (size_t)row * DM + c) = pk;
      }
    }
  }
}

template <bool SCALE_A, bool NOLOAD = false, class Epi>
DI void gemm_tile(int tix, const float* __restrict__ SSQ, const bf16_t* __restrict__ A, int lda, const bf16_t* __restrict__ Bt, int ldb, int K, int m0, int n0, char* smem, const Epi& epi, int kbeg = 0) {
  const int tid = tix, lane = tid & 63, wid = tid >> 6, wr = wid >> 1, wc = wid & 1, fr = lane & 15, fq = lane >> 4;
  bf16_t* sbuf = (bf16_t*)smem;
  constexpr int STG = 2 * 128 * 72;
  f32x4 acc[4][4];
#pragma unroll
  for (int mi = 0; mi < 4; ++mi)
#pragma unroll
    for (int ni = 0; ni < 4; ++ni) acc[mi][ni] = (f32x4){0.f, 0.f, 0.f, 0.f};
  const int lrow = tid >> 3, lcol = (tid & 7) * 8;
  const bf16_t* ga = A + (size_t)(m0 + lrow) * lda + lcol + kbeg;
  const bf16_t* gb = Bt + (size_t)(n0 + lrow) * ldb + lcol + kbeg;
  float rs[4] = {1.f, 1.f, 1.f, 1.f};
  if (SCALE_A) {
#pragma unroll
    for (int i = 0; i < 4; ++i) rs[i] = rsqrtf(SSQ[m0 + lrow + 32 * i] * (1.f / 512.f) + EPSF);
  }
  u32x4 ra[4], rb[4];
  auto gload = [&](int k0) {
#pragma unroll
    for (int i = 0; i < 4; ++i) { ra[i] = *(const u32x4*)(ga + (size_t)(32 * i) * lda + k0); rb[i] = *(const u32x4*)(gb + (size_t)(32 * i) * ldb + k0); }
  };
  auto lstore = [&](int stage, int k0) {
    if (SCALE_A && kbeg + k0 >= 256 && kbeg + k0 < 768) {
#pragma unroll
      for (int i = 0; i < 4; ++i)
#pragma unroll
        for (int q = 0; q < 4; ++q) ra[i][q] = pack2(bflo(ra[i][q]) * rs[i], bfhi(ra[i][q]) * rs[i]);
    }
    bf16_t* sA = sbuf + stage * STG; bf16_t* sB = sA + 128 * 72;
#pragma unroll
    for (int i = 0; i < 4; ++i) { *(u32x4*)(sA + (lrow + 32 * i) * 72 + lcol) = ra[i]; *(u32x4*)(sB + (lrow + 32 * i) * 72 + lcol) = rb[i]; }
  };
  const int nk = K >> 6;
  gload(0);
  __syncthreads();
  lstore(0, 0);
  if (nk > 1) gload(64);
  __syncthreads();
  for (int kt = 0; kt < nk; ++kt) {
    const int cur = kt & 1;
    if (kt + 1 < nk) lstore(cur ^ 1, (kt + 1) * 64);
    if (!NOLOAD && kt + 2 < nk) gload((kt + 2) * 64);
    __builtin_amdgcn_sched_barrier(0);
    const bf16_t* sA = sbuf + cur * STG + (64 * wr + fr) * 72 + 8 * fq;
    const bf16_t* sB = sbuf + cur * STG + 128 * 72 + (64 * wc + fr) * 72 + 8 * fq;
#pragma unroll
    for (int ks = 0; ks < 2; ++ks) {
      bf16x8 a[4], b[4];
#pragma unroll
      for (int i = 0; i < 4; ++i) { a[i] = *(const bf16x8*)(sA + 16 * i * 72 + 32 * ks); b[i] = *(const bf16x8*)(sB + 16 * i * 72 + 32 * ks); }
#pragma unroll
      for (int mi = 0; mi < 4; ++mi)
#pragma unroll
        for (int ni = 0; ni < 4; ++ni) acc[mi][ni] = MFMA16(b[ni], a[mi], acc[mi][ni]);
    }
    __syncthreads();
  }
  epi(acc, m0 + 64 * wr, n0 + 64 * wc, fr, fq);
}

struct EpiInProj {
  bf16_t* U; float* DTRAW;
  DI void operator()(const f32x4 (&acc)[4][4], int mrow, int ncol, int fr, int fq) const {
#pragma unroll
    for (int mi = 0; mi < 4; ++mi) {
      const int row = mrow + 16 * mi + fr;
#pragma unroll
      for (int ni = 0; ni < 4; ++ni) {
        const int col = ncol + 16 * ni + 4 * fq;
        if (col < NIN) {
          u32x2 pk = {pack2(acc[mi][ni][0], acc[mi][ni][1]), pack2(acc[mi][ni][2], acc[mi][ni][3])};
          *(u32x2*)(U + (size_t)row * NIN + col) = pk;
          if (col >= 2304 && col < 2320) *(f32x4*)(DTRAW + row * 16 + col - 2304) = acc[mi][ni];
        }
      }
    }
  }
};
struct EpiResid {
  const float* old_lat; const float* old_ctx; float* new_lat; float* new_ctx; const float* gate_lat; const float* gate_ctx;
  DI void operator()(const f32x4 (&acc)[4][4], int mrow, int ncol, int fr, int fq) const {
#pragma unroll
    for (int mi = 0; mi < 4; ++mi) {
      const int row = mrow + 16 * mi + fr;
      const bool lat = row < L_;
      const float* op = lat ? old_lat + (size_t)row * DM : old_ctx + (size_t)(row - L_) * DM;
      float* np = lat ? new_lat + (size_t)row * DM : new_ctx + (size_t)(row - L_) * DM;
      const float* gp = lat ? gate_lat : gate_ctx;
#pragma unroll
      for (int ni = 0; ni < 4; ++ni) {
        const int col = ncol + 16 * ni + 4 * fq;
        const f32x4 o = *(const f32x4*)(op + col), gt = *(const f32x4*)(gp + col);
        *(f32x4*)(np + col) = o + gt * acc[mi][ni];
      }
    }
  }
};
struct EpiCtxAtomic {
  float* xc; const float* gate;
  DI void operator()(const f32x4 (&acc)[4][4], int mrow, int ncol, int fr, int fq) const {
#pragma unroll
    for (int mi = 0; mi < 4; ++mi) {
      float* np = xc + (size_t)(mrow + 16 * mi + fr - L_) * DM;
#pragma unroll
      for (int ni = 0; ni < 4; ++ni) {
        const int col = ncol + 16 * ni + 4 * fq;
        const f32x4 gt = *(const f32x4*)(gate + col);
#pragma unroll
        for (int j = 0; j < 4; ++j) atomicAdd(np + col + j, gt[j] * acc[mi][ni][j]);
      }
    }
  }
};
struct EpiSwiGLU {
  bf16_t* ACT;
  DI void operator()(const f32x4 (&acc)[4][4], int mrow, int ncol, int fr, int fq) const {
    const int unit0 = (ncol >> 1) + 4 * fq;
#pragma unroll
    for (int mi = 0; mi < 4; ++mi) {
      const int row = mrow + 16 * mi + fr;
#pragma unroll
      for (int ni = 0; ni < 2; ++ni) {
        float o[4];
#pragma unroll
        for (int j = 0; j < 4; ++j) o[j] = siluf(acc[mi][ni][j]) * acc[mi][ni + 2][j];
        u32x2 pk = {pack2(o[0], o[1]), pack2(o[2], o[3])};
        *(u32x2*)(ACT + (size_t)row * FH + unit0 + 16 * ni) = pk;
      }
    }
  }
};

template <bool SCALE_A, bool NOLOAD = false, class Epi>
DI void gemm_tile256(int tix, const float* __restrict__ SSQ, const bf16_t* __restrict__ A, int lda, const bf16_t* __restrict__ Bt, int ldb, int K, int m0, int n0, char* smem, const Epi& epi, int kbeg = 0, int scale_after = -1, bool kperm = false) {
  const int tid = tix, lane = tid & 63, wid = tid >> 6, wr = wid >> 1, wc = wid & 1, fr = lane & 15, fq = lane >> 4;
  bf16_t* sA = (bf16_t*)smem;
  bf16_t* sB = sA + 256 * 72;
  f32x4 acc[8][4];
#pragma unroll
  for (int mi = 0; mi < 8; ++mi)
#pragma unroll
    for (int ni = 0; ni < 4; ++ni) acc[mi][ni] = (f32x4){0.f, 0.f, 0.f, 0.f};
  const int lrow = tid >> 3, lcol = (tid & 7) * 8;
  const bf16_t* ga = A + (size_t)(m0 + lrow) * lda + lcol + kbeg;
  const bf16_t* gb = Bt + (size_t)(n0 + lrow) * ldb + lcol + kbeg;
  u32x4 ra[8], rb[4];
  auto gload = [&](int k0) {
#pragma unroll
    for (int i = 0; i < 8; ++i) ra[i] = *(const u32x4*)(ga + (size_t)(32 * i) * lda + k0);
#pragma unroll
    for (int i = 0; i < 4; ++i) rb[i] = *(const u32x4*)(gb + (size_t)(32 * i) * ldb + k0);
  };
  auto lstore = [&](int k0) {
#pragma unroll
    for (int i = 0; i < 8; ++i) *(u32x4*)(sA + (lrow + 32 * i) * 72 + lcol) = ra[i];
#pragma unroll
    for (int i = 0; i < 4; ++i) *(u32x4*)(sB + (lrow + 32 * i) * 72 + lcol) = rb[i];
  };
  const int nk = K >> 6;
  auto kof = [&](int kt) -> int { return kperm ? (kt < 8 ? 256 + 64 * kt : (kt < 12 ? 64 * (kt - 8) : 768 + 64 * (kt - 12))) : 64 * kt; };
  gload(kof(0));
  for (int kt = 0; kt < nk; ++kt) {
    __syncthreads();
    lstore(kof(kt));
    __syncthreads();
    if (!NOLOAD && kt + 1 < nk) gload(kof(kt + 1));
    const bf16_t* pA = sA + (128 * wr + fr) * 72 + 8 * fq;
    const bf16_t* pB = sB + (64 * wc + fr) * 72 + 8 * fq;
#pragma unroll
    for (int ks = 0; ks < 2; ++ks) {
      bf16x8 b[4];
#pragma unroll
      for (int i = 0; i < 4; ++i) b[i] = *(const bf16x8*)(pB + 16 * i * 72 + 32 * ks);
#pragma unroll
      for (int mh = 0; mh < 4; ++mh) {
        bf16x8 a[2];
#pragma unroll
        for (int i = 0; i < 2; ++i) a[i] = *(const bf16x8*)(pA + 16 * (2 * mh + i) * 72 + 32 * ks);
#pragma unroll
        for (int mi = 0; mi < 2; ++mi)
#pragma unroll
          for (int ni = 0; ni < 4; ++ni) acc[2 * mh + mi][ni] = MFMA16(b[ni], a[mi], acc[2 * mh + mi][ni]);
      }
    }
    if (SCALE_A && kt == scale_after) {
#pragma unroll
      for (int mi = 0; mi < 8; ++mi) {
        const float rs = rsqrtf(SSQ[m0 + 128 * wr + 16 * mi + fr] * (1.f / 512.f) + EPSF);
#pragma unroll
        for (int ni = 0; ni < 4; ++ni) acc[mi][ni] = acc[mi][ni] * rs;
      }
    }
  }
  epi(acc, m0 + 128 * wr, n0 + 64 * wc, fr, fq);
}

struct Epi256InProj {
  bf16_t* U; float* DTRAW;
  DI void operator()(const f32x4 (&acc)[8][4], int mrow, int ncol, int fr, int fq) const {
#pragma unroll
    for (int mi = 0; mi < 8; ++mi) {
      const int row = mrow + 16 * mi + fr;
#pragma unroll
      for (int ni = 0; ni < 4; ++ni) {
        const int col = ncol + 16 * ni + 4 * fq;
        if (col < NIN) {
          u32x2 pk = {pack2(acc[mi][ni][0], acc[mi][ni][1]), pack2(acc[mi][ni][2], acc[mi][ni][3])};
          *(u32x2*)(U + (size_t)row * NIN + col) = pk;
          if (col >= 2304 && col < 2320) *(f32x4*)(DTRAW + row * 16 + col - 2304) = acc[mi][ni];
        }
      }
      __builtin_amdgcn_sched_barrier(0);
    }
  }
};
struct Epi256Resid {
  const float* old_lat; float* new_lat; const float* gate_lat;
  DI void operator()(const f32x4 (&acc)[8][4], int mrow, int ncol, int fr, int fq) const {
#pragma unroll
    for (int mi = 0; mi < 8; ++mi) {
      const int row = mrow + 16 * mi + fr;
      const float* op = old_lat + (size_t)row * DM;
      float* np = new_lat + (size_t)row * DM;
#pragma unroll
      for (int ni = 0; ni < 4; ++ni) {
        const int col = ncol + 16 * ni + 4 * fq;
        const f32x4 o = *(const f32x4*)(op + col), gt = *(const f32x4*)(gate_lat + col);
        *(f32x4*)(np + col) = o + gt * acc[mi][ni];
      }
      __builtin_amdgcn_sched_barrier(0);
    }
  }
};
struct Epi256CtxAtomic {
  float* xc; const float* gate;
  DI void operator()(const f32x4 (&acc)[8][4], int mrow, int ncol, int fr, int fq) const {
#pragma unroll
    for (int mi = 0; mi < 8; ++mi) {
      float* np = xc + (size_t)(mrow + 16 * mi + fr - L_) * DM;
#pragma unroll
      for (int ni = 0; ni < 4; ++ni) {
        const int col = ncol + 16 * ni + 4 * fq;
        const f32x4 gt = *(const f32x4*)(gate + col);
#pragma unroll
        for (int j = 0; j < 4; ++j) atomicAdd(np + col + j, gt[j] * acc[mi][ni][j]);
      }
      __builtin_amdgcn_sched_barrier(0);
    }
  }
};
struct Epi256SwiGLU {
  bf16_t* ACT;
  DI void operator()(const f32x4 (&acc)[8][4], int mrow, int ncol, int fr, int fq) const {
    const int unit0 = (ncol >> 1) + 4 * fq;
#pragma unroll
    for (int mi = 0; mi < 8; ++mi) {
      const int row = mrow + 16 * mi + fr;
#pragma unroll
      for (int ni = 0; ni < 2; ++ni) {
        float o[4];
#pragma unroll
        for (int j = 0; j < 4; ++j) o[j] = siluf(acc[mi][ni][j]) * acc[mi][ni + 2][j];
        u32x2 pk = {pack2(o[0], o[1]), pack2(o[2], o[3])};
        *(u32x2*)(ACT + (size_t)row * FH + unit0 + 16 * ni) = pk;
      }
      __builtin_amdgcn_sched_barrier(0);
    }
  }
};

DI void conv_item(int tix, const Params& p, int layer, int it) {
  const int tb = it >> 2, cgp = it & 3;
  const int lane = tix & 63, tg = tix >> 6;
  const bf16_t* U = (const bf16_t*)(p.ws + OFF_U);
  const int c = cgp * 256 + lane * 4;
  const int row0 = tb * 64 + tg * 16;
  const int seq_lo = (row0 < L_) ? 0 : L_, seq_hi = (row0 < L_) ? L_ : T_;
  f32x4 w[5];
#pragma unroll
  for (int j = 0; j < 5; ++j) w[j] = *(const f32x4*)(p.conv_w + ((size_t)layer * 5 + j) * 1024 + c);
  const f32x4 bias = *(const f32x4*)(p.conv_b + layer * 1024 + c);
  u32x2 xr[20];
#pragma unroll
  for (int i = 0; i < 20; ++i) {
    const int row = row0 + i - 2;
    u32x2 z = {0u, 0u};
    xr[i] = (row >= seq_lo && row < seq_hi) ? *(const u32x2*)(U + (size_t)row * NIN + 1280 + c) : z;
  }
  unsigned o[4][8];
  bf16_t* BC = (bf16_t*)(p.ws + OFF_BC);
#pragma unroll
  for (int i = 0; i < 16; i += 2) {
    float y0[4], y1[4];
#pragma unroll
    for (int q = 0; q < 4; ++q) { y0[q] = bias[q]; y1[q] = bias[q]; }
#pragma unroll
    for (int j = 0; j < 5; ++j) {
      const u32x2 a = xr[i + j], b = xr[i + 1 + j];
      y0[0] += w[j][0] * bflo(a[0]); y0[1] += w[j][1] * bfhi(a[0]); y0[2] += w[j][2] * bflo(a[1]); y0[3] += w[j][3] * bfhi(a[1]);
      y1[0] += w[j][0] * bflo(b[0]); y1[1] += w[j][1] * bfhi(b[0]); y1[2] += w[j][2] * bflo(b[1]); y1[3] += w[j][3] * bfhi(b[1]);
    }
#pragma unroll
    for (int q = 0; q < 4; ++q) { y0[q] = siluf(y0[q]); y1[q] = siluf(y1[q]); o[q][i >> 1] = pack2(y0[q], y1[q]); }
    if (cgp >= 2) {
      u32x2 t0 = {pack2(y0[0], y0[1]), pack2(y0[2], y0[3])}, t1 = {pack2(y1[0], y1[1]), pack2(y1[2], y1[3])};
      *(u32x2*)(BC + (size_t)(row0 + i) * 512 + (c - 512)) = t0;
      *(u32x2*)(BC + (size_t)(row0 + i + 1) * 512 + (c - 512)) = t1;
    }
  }
  if (cgp < 3) {
    bf16_t* XBT = (bf16_t*)(p.ws + OFF_XBT);
    const int gc = row0 >> 7, tl = row0 & 127;
#pragma unroll
    for (int q = 0; q < 4; ++q) {
      u32x4 lo = {o[q][0], o[q][1], o[q][2], o[q][3]}, hi = {o[q][4], o[q][5], o[q][6], o[q][7]};
      u32x4* d = (u32x4*)(XBT + ((size_t)gc * 768 + c + q) * 128 + tl);
      d[0] = lo; d[1] = hi;
    }
  }
}

DI void dt_item(int tix, const Params& p, int layer, int gc, char* smem) {
  const int tid = tix, lane = tid & 63, wid = tid >> 6;
  const float* DTRAW = (const float*)(p.ws + OFF_DTRAW);
  float* DT = (float*)(p.ws + OFF_DT);
  float* AC = (float*)(p.ws + OFF_ACUM);
  if (tid < 128) ((float*)(p.ws + OFF_SSQ))[gc * 128 + tid] = 0.f;
#pragma unroll
  for (int ci = 0; ci < 4; ++ci) {
    const int col = wid * 4 + ci;
    const int d = col >> 3;
    const float bias = p.dt_bias[layer * 16 + col];
    const float a = -__expf(p.a_log[layer * 16 + col]);
    const int i0 = 2 * lane, i1 = 2 * lane + 1;
    const int t0 = d ? 127 - i0 : i0, t1 = d ? 127 - i1 : i1;
    const size_t r0 = (size_t)(gc * 128 + t0) * 16 + col, r1 = (size_t)(gc * 128 + t1) * 16 + col;
    float x0 = DTRAW[r0] + bias, x1 = DTRAW[r1] + bias;
    const float dt0 = x0 > 20.f ? x0 : log1pf(__expf(x0));
    const float dt1 = x1 > 20.f ? x1 : log1pf(__expf(x1));
    const float v0 = dt0 * a, v1 = dt1 * a;
    float s = v0 + v1, inc = s;
    for (int o = 1; o < 64; o <<= 1) { const float n = __int_as_float(__builtin_amdgcn_ds_bpermute((lane - o) << 2, __float_as_int(inc))); if (lane >= o) inc += n; }
    const float excl = inc - s;
    DT[r0] = dt0; DT[r1] = dt1;
    AC[r0] = excl + v0; AC[r1] = excl + v0 + v1;
  }
}

DI void qk_item(int tix, const Params& p, int layer, int it) {
  const int rid2 = it * NT + tix;
  const int half = rid2 & 1, rowid = rid2 >> 1;
  const int tok = rowid / 6, hsel = rowid - tok * 6;
  const bf16_t* U = (const bf16_t*)(p.ws + OFF_U);
  const f32x2* R = (const f32x2*)(p.ws + OFF_ROPE);
  const u32x4* src = (const u32x4*)(U + (size_t)tok * NIN + 2320 + hsel * 64 + 32 * half);
  float x[32];
  float ss = 0.f;
#pragma unroll
  for (int i = 0; i < 4; ++i) {
    const u32x4 v = src[i];
#pragma unroll
    for (int q = 0; q < 4; ++q) { x[8 * i + 2 * q] = bflo(v[q]); x[8 * i + 2 * q + 1] = bfhi(v[q]); }
  }
#pragma unroll
  for (int i = 0; i < 32; ++i) ss += x[i] * x[i];
  ss += shx(ss, 1, tix & 63);
  const float rstd = rsqrtf(ss * (1.f / 64.f) + EPSF);
  const f32x4* nw = (const f32x4*)((hsel < 4 ? p.q_norm_w : p.k_norm_w) + layer * 64 + 32 * half);
#pragma unroll
  for (int i = 0; i < 8; ++i) {
    const f32x4 w = nw[i];
#pragma unroll
    for (int j = 0; j < 4; ++j) x[4 * i + j] = x[4 * i + j] * rstd * w[j];
  }
  if (tok < L_) {
    const int pos = half ? (tok & 63) : (tok >> 6);
#pragma unroll
    for (int j = 0; j < 16; ++j) {
      const f32x2 cs = R[pos * 16 + j];
      const float a = x[j], b = x[16 + j];
      x[j] = a * cs[0] - b * cs[1];
      x[16 + j] = b * cs[0] + a * cs[1];
    }
  }
  const float sc = hsel < 4 ? 0.125f * LOG2E : 1.f;
  u32x4* dst = (hsel < 4) ? (u32x4*)((bf16_t*)(p.ws + OFF_QG) + (size_t)tok * 256 + hsel * 64 + 32 * half)
                          : (u32x4*)((bf16_t*)(p.ws + OFF_KG) + (size_t)tok * 128 + (hsel - 4) * 64 + 32 * half);
#pragma unroll
  for (int i = 0; i < 4; ++i) {
    u32x4 o;
#pragma unroll
    for (int q = 0; q < 4; ++q) o[q] = pack2(x[8 * i + 2 * q] * sc, x[8 * i + 2 * q + 1] * sc);
    dst[i] = o;
  }
}

DI void vtr_item(int tix, const Params& p, int it) {
  const bf16_t* U = (const bf16_t*)(p.ws + OFF_U);
  int row0, c, col0; bf16_t* dst;
  if (it < 260) { row0 = it * 64 + (tix >> 6) * 16; c = (tix & 63) * 4; col0 = 512; dst = (bf16_t*)(p.ws + OFF_VNT); }
  else { row0 = (it - 260) * 128 + (tix >> 5) * 16; c = (tix & 31) * 4; col0 = 2320 + 384; dst = (bf16_t*)(p.ws + OFF_VGT); }
  u32x2 xr[16];
#pragma unroll
  for (int i = 0; i < 16; ++i) xr[i] = *(const u32x2*)(U + (size_t)(row0 + i) * NIN + col0 + c);
#pragma unroll
  for (int q = 0; q < 4; ++q) {
    unsigned o[8];
#pragma unroll
    for (int i = 0; i < 8; ++i) {
      const unsigned a = xr[2 * i][q >> 1], b = xr[2 * i + 1][q >> 1];
      o[i] = (q & 1) ? ((a >> 16) | (b & 0xffff0000u)) : ((a & 0xffffu) | (b << 16));
    }
    u32x4 lo = {o[0], o[1], o[2], o[3]}, hi = {o[4], o[5], o[6], o[7]};
    u32x4* d = (u32x4*)(dst + (size_t)(c + q) * T_ + row0);
    d[0] = lo; d[1] = hi;
  }
}

struct AttnState { f32x16 o[2]; float m, l; };

template <class KF, class VF, class SF>
DI void attn_tile(AttnState& st, int lane, bool first, float cinv, const bf16x8 (&qf)[4], const KF& kf, const VF& vf, const SF& sf) {
  f32x16 s[2];
  const float init = first ? 0.f : -st.m * cinv;
#pragma unroll
  for (int ks = 0; ks < 2; ++ks) {
#pragma unroll
    for (int i = 0; i < 16; ++i) s[ks][i] = init;
#pragma unroll
    for (int kk = 0; kk < 4; ++kk) s[ks] = MFMA32(kf(ks, kk), qf[kk], s[ks]);
  }
  sf(s);
  if (first) {
    float mx = fmaxf(s[0][0], s[1][0]);
#pragma unroll
    for (int i = 1; i < 16; ++i) mx = fmaxf(mx, fmaxf(s[0][i], s[1][i]));
    mx = fmaxf(mx, shx(mx, 32, lane));
    if (mx == -INFINITY) mx = 0.f;
    st.m = mx;
#pragma unroll
    for (int i = 0; i < 16; ++i) { s[0][i] -= mx; s[1][i] -= mx; }
  }
  float sum = 0.f;
#pragma unroll
  for (int ks = 0; ks < 2; ++ks)
#pragma unroll
    for (int i = 0; i < 16; ++i) { const float pv = __builtin_amdgcn_exp2f(s[ks][i]); s[ks][i] = pv; sum += pv; }
  sum += shx(sum, 32, lane);
  if (__any(sum > 65536.f)) {
    const float delta = sum > 65536.f ? ceilf(__log2f(sum)) : 0.f;
    const float sc = __builtin_amdgcn_exp2f(-delta);
    st.m += delta; st.l *= sc; sum *= sc;
#pragma unroll
    for (int i = 0; i < 16; ++i) { s[0][i] *= sc; s[1][i] *= sc; st.o[0][i] *= sc; st.o[1][i] *= sc; }
  }
  st.l += sum;
#pragma unroll
  for (int ks = 0; ks < 2; ++ks) {
    const bf16x8 p0 = pack8<0>(s[ks]), p1 = pack8<1>(s[ks]);
#pragma unroll
    for (int dt = 0; dt < 2; ++dt) {
      st.o[dt] = MFMA32(vf(dt, ks, 0), p0, st.o[dt]);
      st.o[dt] = MFMA32(vf(dt, ks, 1), p1, st.o[dt]);
    }
  }
}
DI void attn_store(const AttnState& st, bf16_t* __restrict__ dst  , int hh) {
  const float inv = 1.f / st.l;
#pragma unroll
  for (int dt = 0; dt < 2; ++dt)
#pragma unroll
    for (int g = 0; g < 4; ++g) {
      u32x2 pk = {pack2(st.o[dt][4 * g] * inv, st.o[dt][4 * g + 1] * inv), pack2(st.o[dt][4 * g + 2] * inv, st.o[dt][4 * g + 3] * inv)};
      *(u32x2*)(dst + 32 * dt + 8 * g + 4 * hh) = pk;
    }
}

DI void gqa_item(int tix, const Params& p, int qrow0, int g, int kt0, int kt1, char* smem) {
  const int tid = tix, lane = tid & 63, wid = tid >> 6, r = lane & 31, hh = lane >> 5;
  const int head = 2 * g + (wid >> 1), qsub = wid & 1;
  const bf16_t* QG = (const bf16_t*)(p.ws + OFF_QG);
  const bf16_t* KG = (const bf16_t*)(p.ws + OFF_KG);
  const bf16_t* VGT = (const bf16_t*)(p.ws + OFF_VGT);
  bf16_t* Y = (bf16_t*)(p.ws + OFF_A1);
  bf16_t* sbuf = (bf16_t*)smem;
  constexpr int STG = 64 * 72 + 64 * 68;
  const int qrow = qrow0 + 32 * qsub + r;
  bf16x8 qf[4];
#pragma unroll
  for (int kk = 0; kk < 4; ++kk) qf[kk] = *(const bf16x8*)(QG + (size_t)qrow * 256 + head * 64 + 16 * kk + 8 * hh);
  AttnState st; st.o[0] = zero16(); st.o[1] = zero16(); st.m = 0.f; st.l = 0.f;
  const int lrow = tid >> 3, lcol = (tid & 7) * 8;
  const bf16_t* gk = KG + (size_t)lrow * 128 + g * 64 + lcol;
  const bf16_t* gv = VGT + (size_t)(g * 64 + lrow) * T_ + lcol;
  u32x4 rk0[2], rv0[2], rk1[2], rv1[2];
  auto gload = [&](int kt, u32x4 (&rk)[2], u32x4 (&rv)[2]) {
    if (kt < kt1) {
      const size_t key0 = (size_t)kt * 64;
      rk[0] = *(const u32x4*)(gk + key0 * 128); rk[1] = *(const u32x4*)(gk + (key0 + 32) * 128);
      rv[0] = *(const u32x4*)(gv + key0); rv[1] = *(const u32x4*)(gv + (size_t)32 * T_ + key0);
    }
  };
  auto lstore = [&](int stage, const u32x4 (&rk)[2], const u32x4 (&rv)[2]) {
    bf16_t* sK = sbuf + stage * STG; bf16_t* sV = sK + 64 * 72;
    *(u32x4*)(sK + lrow * 72 + lcol) = rk[0]; *(u32x4*)(sK + (lrow + 32) * 72 + lcol) = rk[1];
    u32x2 a = {rv[0][0], rv[0][1]}, b = {rv[0][2], rv[0][3]}, c = {rv[1][0], rv[1][1]}, d = {rv[1][2], rv[1][3]};
    *(u32x2*)(sV + lrow * 68 + lcol) = a; *(u32x2*)(sV + lrow * 68 + lcol + 4) = b;
    *(u32x2*)(sV + (lrow + 32) * 68 + lcol) = c; *(u32x2*)(sV + (lrow + 32) * 68 + lcol + 4) = d;
  };
  auto compute = [&](int stage, bool first) {
    const bf16_t* sK = sbuf + stage * STG; const bf16_t* sV = sK + 64 * 72;
    auto kf = [&](int ks, int kk) -> bf16x8 { return *(const bf16x8*)(sK + (32 * ks + r) * 72 + 16 * kk + 8 * hh); };
    auto vf = [&](int dt, int ks, int step) -> bf16x8 {
      const bf16_t* b = sV + (32 * dt + r) * 68 + 32 * ks + 16 * step + 4 * hh;
      return cat44(*(const u32x2*)b, *(const u32x2*)(b + 8));
    };
    auto sf = [&](f32x16 (&sx)[2]) {};
    attn_tile(st, lane, first, 1.f, qf, kf, vf, sf);
  };
  gload(kt0, rk0, rv0); gload(kt0 + 1, rk1, rv1);
  __syncthreads();
  lstore(0, rk0, rv0);
  gload(kt0 + 2, rk0, rv0);
  __syncthreads();
  for (int kt = kt0; kt < kt1; kt += 2) {
    lstore(1, rk1, rv1);
    gload(kt + 3, rk1, rv1);
    __builtin_amdgcn_sched_barrier(0);
    compute(0, kt == kt0);
    __syncthreads();
    if (kt + 2 < kt1) lstore(0, rk0, rv0);
    gload(kt + 4, rk0, rv0);
    __builtin_amdgcn_sched_barrier(0);
    compute(1, false);
    __syncthreads();
  }
  attn_store(st, Y + (size_t)qrow * DM + 768 + head * 64, hh);
}

DI void na_item(int tix, const Params& p, int layer, int rowidx, int hp, bool is_ctx, char* smem) {
  const int tid = tix, lane = tid & 63, wid = tid >> 6, r = lane & 31, hh = lane >> 5;
  const int head = 2 * hp + (wid >> 1), qsub = wid & 1;
  const bf16_t* U = (const bf16_t*)(p.ws + OFF_U);
  const bf16_t* VNT = (const bf16_t*)(p.ws + OFF_VNT);
  bf16_t* Y = (bf16_t*)(p.ws + OFF_A1);
  float* srpb = (float*)smem;
  __syncthreads();
  for (int i = tid; i < 2 * 465; i += NT) srpb[i] = p.na_rpb[((size_t)layer * 4 + 2 * hp) * 465 + i] * LOG2E;
  __syncthreads();
  const float* myrpb = srpb + (wid >> 1) * 465;
  const int qc = 32 * qsub + r;
  const int qrow = (is_ctx ? L_ + rowidx * 64 : rowidx * 64) + qc;
  bf16x8 qf[4];
#pragma unroll
  for (int kk = 0; kk < 4; ++kk) qf[kk] = *(const bf16x8*)(U + (size_t)qrow * NIN + head * 64 + 16 * kk + 8 * hh);
  AttnState st; st.o[0] = zero16(); st.o[1] = zero16(); st.m = 0.f; st.l = 0.f;
  const float c1 = 0.125f * LOG2E;
  const int r_start = min(max(rowidx - 4, 0), 248);
  const int cs = min(max(qc - 8, 0), 48);
  const int ntile = is_ctx ? 4 : 12;
  auto tok_of = [&](int t) -> int { const bool w = (!is_ctx) && (t < 8); return w ? (r_start + t) * 64 : L_ + (is_ctx ? t : t - 8) * 64; };
  bf16x8 kreg[8], kregn[8];
  auto ldK = [&](int t, bf16x8 (&kr)[8]) {
    const bf16_t* kb = U + (size_t)tok_of(t) * NIN + 256 + head * 64 + 8 * hh;
#pragma unroll
    for (int ks = 0; ks < 2; ++ks)
#pragma unroll
      for (int kk = 0; kk < 4; ++kk) kr[ks * 4 + kk] = *(const bf16x8*)(kb + (size_t)(32 * ks + r) * NIN + 16 * kk);
  };
  ldK(0, kreg);
#pragma unroll 1
  for (int t = 0; t < ntile; ++t) {
    const bool win = (!is_ctx) && (t < 8);
    const int tok0 = tok_of(t);
    const bf16_t* vb = VNT + (size_t)(head * 64) * T_ + tok0 + 4 * hh;
    u32x2 vreg[32];
#pragma unroll
    for (int dt = 0; dt < 2; ++dt)
#pragma unroll
      for (int ks = 0; ks < 2; ++ks)
#pragma unroll
        for (int step = 0; step < 2; ++step) {
          const bf16_t* b = vb + (size_t)(32 * dt + r) * T_ + 32 * ks + 16 * step;
          vreg[((dt * 2 + ks) * 2 + step) * 2] = *(const u32x2*)b; vreg[((dt * 2 + ks) * 2 + step) * 2 + 1] = *(const u32x2*)(b + 8);
        }
    if (t + 1 < ntile) ldK(t + 1, kregn);
    __builtin_amdgcn_sched_barrier(0);
    auto kf = [&](int ks, int kk) -> bf16x8 { return kreg[ks * 4 + kk]; };
    auto vf = [&](int dt, int ks, int step) -> bf16x8 { return cat44(vreg[((dt * 2 + ks) * 2 + step) * 2], vreg[((dt * 2 + ks) * 2 + step) * 2 + 1]); };
    const float* rp = myrpb + (r_start + t - rowidx + 7) * 31 + 15 - qc;
    auto sf = [&](f32x16 (&s)[2]) {
#pragma unroll
      for (int ks = 0; ks < 2; ++ks)
#pragma unroll
        for (int i = 0; i < 16; ++i) {
          const int kc = 32 * ks + crow(i, hh);
          if (win) {
            const bool ok = (kc >= cs) && (kc < cs + 16);
            s[ks][i] = ok ? (s[ks][i] * c1 + rp[ok ? kc : qc]) : -INFINITY;
          } else s[ks][i] = s[ks][i] * c1;
        }
    };
    attn_tile(st, lane, t == 0, 1.f / c1, qf, kf, vf, sf);
    if (t + 1 < ntile) {
#pragma unroll
      for (int j = 0; j < 8; ++j) kreg[j] = kregn[j];
    }
  }
  attn_store(st, Y + (size_t)qrow * DM + head * 64, hh);
}

DI void ssd_s1_item(int tix, const Params& p, int gc, int h, char* smem) {
  const int tid = tix, lane = tid & 63, wid = tid >> 6, r = lane & 31, hh = lane >> 5;
  const float* DT = (const float*)(p.ws + OFF_DT);
  const float* AC = (const float*)(p.ws + OFF_ACUM);
  float* CDEC = (float*)(p.ws + OFF_CDEC);
  const bf16_t* XBT = (const bf16_t*)(p.ws + OFF_XBT) + (size_t)gc * 768 * 128;
  bf16_t* ST = (bf16_t*)(p.ws + OFF_ST);
  float* sw = (float*)smem;
  __syncthreads();
  {
    const int d = tid >> 7, t = tid & 127, col = d * 8 + h;
    const float tot = AC[(size_t)(gc * 128 + (d ? 0 : 127)) * 16 + col];
    const float ac = AC[(size_t)(gc * 128 + t) * 16 + col], dt = DT[(size_t)(gc * 128 + t) * 16 + col];
    sw[d * 128 + t] = __expf(tot - ac) * dt;
    if (t == 0) CDEC[(d * 8 + h) * NCH + gc] = __expf(tot);
  }
  __syncthreads();
  const int g = h >> 2;
  f32x16 acc[2][2];
  acc[0][0] = zero16(); acc[0][1] = zero16(); acc[1][0] = zero16(); acc[1][1] = zero16();
#pragma unroll
  for (int kk = 0; kk < 8; ++kk) {
    const int kb = 16 * kk + 8 * hh;
    const bf16x8 bfrag = *(const bf16x8*)(XBT + (size_t)(512 + g * 128 + 32 * wid + r) * 128 + kb);
    float wf[8], wb[8];
#pragma unroll
    for (int j = 0; j < 8; ++j) { wf[j] = sw[kb + j]; wb[j] = sw[128 + kb + j]; }
#pragma unroll
    for (int mt = 0; mt < 2; ++mt) {
      const u32x4 xr = *(const u32x4*)(XBT + (size_t)(h * 64 + 32 * mt + r) * 128 + kb);
      u32x4 af, ab;
#pragma unroll
      for (int q = 0; q < 4; ++q) {
        const float lo = bflo(xr[q]), hi = bfhi(xr[q]);
        af[q] = pack2(lo * wf[2 * q], hi * wf[2 * q + 1]);
        ab[q] = pack2(lo * wb[2 * q], hi * wb[2 * q + 1]);
      }
      acc[0][mt] = MFMA32(bfrag, __builtin_bit_cast(bf16x8, af), acc[0][mt]);
      acc[1][mt] = MFMA32(bfrag, __builtin_bit_cast(bf16x8, ab), acc[1][mt]);
    }
  }
#pragma unroll
  for (int d = 0; d < 2; ++d)
#pragma unroll
    for (int mt = 0; mt < 2; ++mt)
#pragma unroll
      for (int q4 = 0; q4 < 4; ++q4) {
        const int pp = 32 * mt + r, n = 32 * wid + 8 * q4 + 4 * hh;
        u32x2 pk = {pack2(acc[d][mt][4 * q4], acc[d][mt][4 * q4 + 1]), pack2(acc[d][mt][4 * q4 + 2], acc[d][mt][4 * q4 + 3])};
        *(u32x2*)(ST + ((size_t)(d * 8 + h) * NCH + gc) * 8192 + pp * 128 + n) = pk;
      }
}

DI void ssd_scan_item(int tix, const Params& p, int it) {
  const int e2 = it * NT + tix;
  const int dh = e2 >> 12, within = e2 & 4095, d = dh >> 3;
  unsigned* ST = (unsigned*)(p.ws + OFF_ST) + (size_t)dh * NCH * 4096 + within;
  const float* CDEC = (const float*)(p.ws + OFF_CDEC) + dh * NCH;
  float r0 = 0.f, r1 = 0.f;
  for (int b = 0; b < 3; ++b) {
    unsigned v[44]; float dec[44];
#pragma unroll
    for (int j = 0; j < 44; ++j) {
      const int i = b * 44 + j;
      if (i < NCH) {
        const int gc = d ? (129 - i) : (i < 2 ? 128 + i : i - 2);
        v[j] = ST[(size_t)gc * 4096]; dec[j] = CDEC[gc];
      }
    }
#pragma unroll
    for (int j = 0; j < 44; ++j) {
      const int i = b * 44 + j;
      if (i < NCH) {
        const int gc = d ? (129 - i) : (i < 2 ? 128 + i : i - 2);
        ST[(size_t)gc * 4096] = pack2(r0, r1);
        r0 = dec[j] * r0 + bflo(v[j]); r1 = dec[j] * r1 + bfhi(v[j]);
      }
    }
  }
}

DI void ssd_s3_item(int tix, const Params& p, int layer, int gc, int tq, int g, char* smem, bool do_atomic) {
  const int tid = tix, lane = tid & 63, wid = tid >> 6, r = lane & 31, hh = lane >> 5;
  const float* DT = (const float*)(p.ws + OFF_DT);
  const float* AC = (const float*)(p.ws + OFF_ACUM);
  const bf16_t* XBT = (const bf16_t*)(p.ws + OFF_XBT) + (size_t)gc * 768 * 128;
  const bf16_t* BC = (const bf16_t*)(p.ws + OFF_BC) + (size_t)gc * 128 * 512;
  const bf16_t* ST = (const bf16_t*)(p.ws + OFF_ST);
  const bf16_t* U = (const bf16_t*)(p.ws + OFF_U);
  bf16_t* Y = (bf16_t*)(p.ws + OFF_A1);
  float* SSQ = (float*)(p.ws + OFF_SSQ);
  float* sAc = (float*)smem;
  float* sDt = sAc + 16 * 128;
  const int h = 4 * g + wid;
  const int tl = 32 * tq + r;
  const size_t trow = (size_t)gc * 128 + tl;
  f32x4 fa[2], fd[2];
#pragma unroll
  for (int i = 0; i < 2; ++i) { fa[i] = *(const f32x4*)(AC + (size_t)(gc * 128) * 16 + 4 * (tid + NT * i)); fd[i] = *(const f32x4*)(DT + (size_t)(gc * 128) * 16 + 4 * (tid + NT * i)); }
  bf16x8 cf[8];
#pragma unroll
  for (int kk = 0; kk < 8; ++kk) cf[kk] = *(const bf16x8*)(BC + (size_t)tl * 512 + 256 + g * 128 + 16 * kk + 8 * hh);
  bf16x8 bfc[8], bfn[8]; u32x2 xac[8], xan[8];
  auto ldB = [&](int stl, bf16x8 (&bf)[8], u32x2 (&xa)[8]) {
#pragma unroll
    for (int kk = 0; kk < 8; ++kk) bf[kk] = *(const bf16x8*)(BC + (size_t)(32 * stl + r) * 512 + g * 128 + 16 * kk + 8 * hh);
    const bf16_t* xb0 = XBT + (size_t)(h * 64 + r) * 128 + 32 * stl + 4 * hh;
#pragma unroll
    for (int q = 0; q < 4; ++q) { xa[q] = *(const u32x2*)(xb0 + 8 * q); xa[4 + q] = *(const u32x2*)(xb0 + 32 * 128 + 8 * q); }
  };
  ldB(0, bfc, xac);
  __syncthreads();
#pragma unroll
  for (int i = 0; i < 2; ++i) { *(f32x4*)(sAc + 4 * (tid + NT * i)) = fa[i]; *(f32x4*)(sDt + 4 * (tid + NT * i)) = fd[i]; }
  __syncthreads();
  const float acf_t = sAc[tl * 16 + h], acb_t = sAc[tl * 16 + 8 + h];
  const float Dh = p.ssd_d[layer * 8 + h];
  f32x16 y[2]; y[0] = zero16(); y[1] = zero16();
  u32x2 zz[8];
#pragma unroll
  for (int stl = 0; stl < 4; ++stl) {
    if (stl < 3) ldB(stl + 1, bfn, xan);
    else {
#pragma unroll
      for (int q = 0; q < 8; ++q) zz[q] = *(const u32x2*)(U + trow * NIN + 768 + h * 64 + 32 * (q >> 2) + 8 * (q & 3) + 4 * hh);
    }
    __builtin_amdgcn_sched_barrier(0);
    f32x16 gt = zero16();
#pragma unroll
    for (int kk = 0; kk < 8; ++kk) gt = MFMA32(bfc[kk], cf[kk], gt);
    f32x16 pt;
#pragma unroll
    for (int reg = 0; reg < 16; ++reg) {
      const int s = 32 * stl + crow(reg, hh);
      float f = 0.f;
      if (s <= tl) f += __expf(acf_t - sAc[s * 16 + h]) * sDt[s * 16 + h];
      if (s >= tl) f += __expf(acb_t - sAc[s * 16 + 8 + h]) * sDt[s * 16 + 8 + h];
      pt[reg] = gt[reg] * f + (s == tl ? Dh : 0.f);
    }
    const bf16x8 p0 = pack8<0>(pt), p1 = pack8<1>(pt);
    y[0] = MFMA32(cat44(xac[0], xac[1]), p0, y[0]); y[0] = MFMA32(cat44(xac[2], xac[3]), p1, y[0]);
    y[1] = MFMA32(cat44(xac[4], xac[5]), p0, y[1]); y[1] = MFMA32(cat44(xac[6], xac[7]), p1, y[1]);
    if (stl < 3) {
#pragma unroll
      for (int kk = 0; kk < 8; ++kk) bfc[kk] = bfn[kk];
#pragma unroll
      for (int q = 0; q < 8; ++q) xac[q] = xan[q];
    }
  }
#pragma unroll
  for (int d = 0; d < 2; ++d) {
    const bf16_t* Hb = ST + ((size_t)(d * 8 + h) * NCH + gc) * 8192;
    bf16x8 hf[2][8];
#pragma unroll
    for (int mt = 0; mt < 2; ++mt)
#pragma unroll
      for (int kk = 0; kk < 8; ++kk) hf[mt][kk] = *(const bf16x8*)(Hb + (size_t)(32 * mt + r) * 128 + 16 * kk + 8 * hh);
    f32x16 a2[2]; a2[0] = zero16(); a2[1] = zero16();
#pragma unroll
    for (int kk = 0; kk < 8; ++kk) { a2[0] = MFMA32(hf[0][kk], cf[kk], a2[0]); a2[1] = MFMA32(hf[1][kk], cf[kk], a2[1]); }
    const float e = __expf(d ? acb_t : acf_t);
#pragma unroll
    for (int mt = 0; mt < 2; ++mt)
#pragma unroll
      for (int reg = 0; reg < 16; ++reg) y[mt][reg] += e * a2[mt][reg];
  }
  float ssq = 0.f;
#pragma unroll
  for (int mt = 0; mt < 2; ++mt)
#pragma unroll
    for (int q4 = 0; q4 < 4; ++q4) {
      const int p0 = 32 * mt + 8 * q4 + 4 * hh;
      const u32x2 z2 = zz[4 * mt + q4];
      const f32x4 nw = *(const f32x4*)(p.ssd_norm_w + layer * 512 + h * 64 + p0);
      float zv[4] = {bflo(z2[0]), bfhi(z2[0]), bflo(z2[1]), bfhi(z2[1])};
      float o[4];
#pragma unroll
      for (int j = 0; j < 4; ++j) {
        const float yy = y[mt][4 * q4 + j] * siluf(zv[j]);
        ssq += yy * yy;
        o[j] = yy * nw[j];
      }
      u32x2 pk = {pack2(o[0], o[1]), pack2(o[2], o[3])};
      *(u32x2*)(Y + trow * DM + 256 + h * 64 + p0) = pk;
    }
  ssq += shx(ssq, 32, lane);
  if (hh == 0 && do_atomic) atomicAdd(SSQ + trow, ssq);
}

DI int xcd_chunk(int j, int total) {
  const int q = total >> 3, rr = total & 7, x = j & 7, off = j >> 3;
  return (x < rr ? x * (q + 1) : rr * (q + 1) + (x - rr) * q) + off;
}
DI void tile_swz(int it, int nM, int nN, int& pm, int& pn) {
  constexpr int NX = 8, WGM = 8;
  const int total = nM * nN, q = total / NX, rr = total % NX, xcd = it % NX, off = it / NX;
  const int wgid = (xcd < rr ? xcd * (q + 1) : rr * (q + 1) + (xcd - rr) * q) + off;
  const int nig = WGM * nN, gid = wgid / nig, fm = gid * WGM, gsz = min(nM - fm, WGM);
  pm = fm + (wgid % nig) % gsz; pn = (wgid % nig) / gsz;
}

enum { PH_INIT = 0, PH_NORM1, PH_INPROJ, PH_PREP, PH_MIX1, PH_SCAN, PH_S3, PH_OUTPROJ, PH_NORM2, PH_FFN1, PH_FFN2, PH_FINAL };

DI void run_phase(const Params& p, int ph, int layer, int bid, int nb, char* smem, bool last_rep = true) {
  int tix = threadIdx.x;
  asm volatile("" : "+v"(tix));
  const bool ctx_out = layer < 1;
  const float* MOD = (const float*)(p.ws + OFF_MOD);
  switch (ph) {
    case PH_INIT: {
      const int total = 192 + 16 + 64 + WC_TOTAL;
      for (int it = bid; it < total; it += nb) {
        int tx = tix; asm volatile("" : "+v"(tx));
        if (it < 192) mod_item(tx, p, it, smem);
        else if (it < 208) rope_item(tx, p, it - 192);
        else if (it < 272) {
          const f32x4* src = (const f32x4*)(p.ctx + (size_t)(it - 208) * 4096); f32x4* dst = (f32x4*)((float*)(p.ws + OFF_XC) + (size_t)(it - 208) * 4096);
#pragma unroll
          for (int i = 0; i < 4; ++i) dst[tx + NT * i] = src[tx + NT * i];
        }
        else wconv_item(tx, p, 0, it - 272, smem);
      }
    } break;
    case PH_NORM1: {
      const int total = T_ / 8 + (layer > 0 ? WC_TOTAL : 0);
      for (int it = bid; it < total; it += nb) {
        int tx = tix; asm volatile("" : "+v"(tx));
        if (it < T_ / 8) norm_item(tx, p, layer, 0, it);
        else wconv_item(tx, p, layer, it - T_ / 8, smem);
      }
    } break;
    case PH_INPROJ: {
      Epi256InProj epi{(bf16_t*)(p.ws + OFF_U), (float*)(p.ws + OFF_DTRAW)};
      const int total = 65 * 23;
      for (int it = bid; it < total; it += nb) {
        int tx = tix; asm volatile("" : "+v"(tx));
#ifdef PROBE_NOLOAD
        if (!last_rep) gemm_tile256<false, true>(tx, nullptr, (const bf16_t*)(p.ws + OFF_A1), DM, (const bf16_t*)(p.ws + OFF_WIN), DM, DM, (it / 23) * 256, (it % 23) * 128, smem, epi); else
#endif
        { int pm, pn; tile_swz(it, 65, 23, pm, pn);
          gemm_tile256<false>(tx, nullptr, (const bf16_t*)(p.ws + OFF_A1), DM, (const bf16_t*)(p.ws + OFF_WIN), DM, DM, pm * 256, pn * 128, smem, epi); }
      }
    } break;
    case PH_PREP: {
      const int n0 = 260 * 4, n1 = n0 + NCH, n2 = n1 + 780, n3 = n2 + 260 + 130;
      for (int it = bid; it < n3; it += nb) {
        int tx = tix; asm volatile("" : "+v"(tx));
        if (it < n0) conv_item(tx, p, layer, it);
        else if (it < n1) dt_item(tx, p, layer, it - n0, smem);
        else if (it < n2) qk_item(tx, p, layer, it - n1);
        else vtr_item(tx, p, it - n2);
      }
    } break;
    case PH_MIX1: {
      const int nctx = ctx_out ? 8 : 0;
      const int n0 = 512, n1 = n0 + nctx, n2 = n1 + 512, n3 = n2 + nctx, n4 = n3 + NCH * 8;
      const int nround = (n4 + nb - 1) / nb;
      for (int kk = 0; kk < nround; ++kk) {
        const int k = (bid >= (nb >> 1)) ? ((kk + 1 == nround) ? 0 : kk + 1) : kk;
        const int it = bid + k * nb;
        if (it >= n4) continue;
        int tx = tix; asm volatile("" : "+v"(tx));
        if (it < n0) gqa_item(tx, p, ((it & 3) + 4 * (it >> 3)) * 64, (it >> 2) & 1, 0, 260, smem);
        else if (it < n1) { const int j = it - n0; gqa_item(tx, p, L_ + (j >> 1) * 64, j & 1, 256, 260, smem); }
        else if (it < n2) { const int j = xcd_chunk(it - n1, 512); na_item(tx, p, layer, j >> 1, j & 1, false, smem); }
        else if (it < n3) { const int j = it - n2; na_item(tx, p, layer, j >> 1, j & 1, true, smem); }
        else { const int j = xcd_chunk(it - n3, NCH * 8); ssd_s1_item(tx, p, j >> 3, j & 7, smem); }
      }
    } break;
    case PH_SCAN: {
      for (int it = bid; it < 256; it += nb) ssd_scan_item(tix, p, it);
    } break;
    case PH_S3: {
      const int total = (ctx_out ? NCH : 128) * 8;
      for (int it = bid; it < total; it += nb) {
        int tx = tix; asm volatile("" : "+v"(tx));
        const int j = xcd_chunk(it, total);
        ssd_s3_item(tx, p, layer, j >> 3, (j >> 1) & 3, j & 1, smem, last_rep);
      }
    } break;
    case PH_OUTPROJ: {
      EpiResid epi{layer == 0 ? p.x : p.out, (const float*)(p.ws + OFF_XC), p.out, (float*)(p.ws + OFF_XC),
                   MOD + (layer * 2 + 0) * 6144 + 2 * DM, MOD + (layer * 2 + 1) * 6144 + 2 * DM};
      EpiCtxAtomic epc{(float*)(p.ws + OFF_XC), MOD + (layer * 2 + 1) * 6144 + 2 * DM};
      const int nsplit = ctx_out ? 64 : 0;
      const int total = nsplit + 128 * 8;
      for (int it = bid; it < total; it += nb) {
        int tx = tix; asm volatile("" : "+v"(tx));
        if (it < nsplit) { const int tile = it >> 2, kq = it & 3;
          gemm_tile<true>(tx, (const float*)(p.ws + OFF_SSQ), (const bf16_t*)(p.ws + OFF_A1), DM, (const bf16_t*)(p.ws + OFF_WOUT), DM, DM / 4, L_ + (tile >> 3) * 128, (tile & 7) * 128, smem, epc, kq * (DM / 4));
        } else { const int j = it - nsplit; int pm, pn; tile_swz(j, 128, 8, pm, pn);
          gemm_tile<true>(tx, (const float*)(p.ws + OFF_SSQ), (const bf16_t*)(p.ws + OFF_A1), DM, (const bf16_t*)(p.ws + OFF_WOUT), DM, DM, pm * 128, pn * 128, smem, epi);
        }
      }
    } break;
    case PH_NORM2: {
      const int total = (ctx_out ? T_ : L_) / 8;
      for (int it = bid; it < total; it += nb) norm_item(tix, p, layer, 1, it);
    } break;
    case PH_FFN1: {
      Epi256SwiGLU epi{(bf16_t*)(p.ws + OFF_U)};
      const int total = (ctx_out ? 65 : 64) * 44;
      for (int it = bid; it < total; it += nb) {
        int tx = tix; asm volatile("" : "+v"(tx));
#ifdef PROBE_NOLOAD
        if (!last_rep) gemm_tile256<false, true>(tx, nullptr, (const bf16_t*)(p.ws + OFF_A1), DM, (const bf16_t*)(p.ws + OFF_WGU), DM, DM, (it / 44) * 256, (it % 44) * 128, smem, epi); else
#endif
        { int pm, pn; tile_swz(it, ctx_out ? 65 : 64, 44, pm, pn);
          gemm_tile256<false>(tx, nullptr, (const bf16_t*)(p.ws + OFF_A1), DM, (const bf16_t*)(p.ws + OFF_WGU), DM, DM, pm * 256, pn * 128, smem, epi); }
      }
    } break;
    case PH_FFN2: {
      Epi256Resid epi{p.out, p.out, MOD + (layer * 2 + 0) * 6144 + 5 * DM};
      Epi256CtxAtomic epc{(float*)(p.ws + OFF_XC), MOD + (layer * 2 + 1) * 6144 + 5 * DM};
      const int nsplit = ctx_out ? 32 : 0;
      const int total = nsplit + 64 * 8;
      for (int it = bid; it < total; it += nb) {
        int tx = tix; asm volatile("" : "+v"(tx));
        if (it < nsplit) { const int tile = it >> 2, kq = it & 3;
          gemm_tile256<false>(tx, nullptr, (const bf16_t*)(p.ws + OFF_U), FH, (const bf16_t*)(p.ws + OFF_WD), FH, FH / 4, L_, tile * 128, smem, epc, kq * (FH / 4));
        } else { const int j = it - nsplit; int pm, pn; tile_swz(j, 64, 8, pm, pn);
          gemm_tile256<false>(tx, nullptr, (const bf16_t*)(p.ws + OFF_U), FH, (const bf16_t*)(p.ws + OFF_WD), FH, FH, pm * 256, pn * 128, smem, epi);
        }
      }
    } break;
    case PH_FINAL: {
      for (int it = bid; it < L_ / 8; it += nb) norm_item(tix, p, 1, 2, it);
    } break;
  }
}

#define XB_TMO      128
#define XB_XCNT(j)  (256  + 64 * (j))
#define XB_XSUB(j)  (1280 + 64 * (j))
#define XB_XGEN(j)  (2304 + 64 * (j))
#define XB_TOP      3328
#define XB_TOPGEN   3392
#define XB_SPIN_CAP (1u << 22)
DI unsigned xb_ld(unsigned* p) { return __hip_atomic_load(p, __ATOMIC_RELAXED, __HIP_MEMORY_SCOPE_AGENT); }
DI unsigned xb_add(unsigned* p, unsigned v) { return __hip_atomic_fetch_add(p, v, __ATOMIC_RELAXED, __HIP_MEMORY_SCOPE_AGENT); }
DI unsigned xb_xcc_id() { return (unsigned)__builtin_amdgcn_s_getreg((3 << 11) | 20) & 0xFu; }
#define XB_SPIN(cond, bar) do { unsigned _sp = 0; while (cond) { __builtin_amdgcn_s_sleep(1); \
    if ((++_sp & 255u) == 0u) { if (xb_ld(&(bar)[XB_TMO])) break; if (_sp > XB_SPIN_CAP) { atomicAdd(&(bar)[XB_TMO], 1u); break; } } } } while (0)
DI void xb_complete(unsigned* bar, unsigned x, unsigned G, unsigned& nloc, unsigned& nx) {
  unsigned sum, cnt, mine, sp = 0u;
  for (;;) {
    sum = 0u; cnt = 0u; mine = 0u;
#pragma unroll
    for (unsigned j = 0; j < 16; ++j) { const unsigned c = xb_ld(&bar[XB_XCNT(j)]); sum += c; cnt += (c > 0u) ? 1u : 0u; mine = (j == x) ? c : mine; }
    if (sum == G) break;
    __builtin_amdgcn_s_sleep(1);
    if ((++sp & 255u) == 0u) { if (xb_ld(&bar[XB_TMO])) break; if (sp > XB_SPIN_CAP) { atomicAdd(&bar[XB_TMO], 1u); break; } }
  }
  nloc = mine > 0u ? mine : 1u; nx = cnt > 0u ? cnt : 1u;
}
DI void grid_barrier(unsigned* bar, volatile unsigned* st, unsigned x, unsigned G) {
  asm volatile("s_waitcnt vmcnt(0)" ::: "memory");
  __syncthreads();
  if (threadIdx.x == 0) {
    __builtin_amdgcn_s_waitcnt(0);
    unsigned nloc = st[0], nx = st[1];
    if (nloc == 0u) { xb_complete(bar, x, G, nloc, nx); st[0] = nloc; st[1] = nx; }
    const unsigned old = xb_add(&bar[XB_XSUB(x)], 1u);
    const unsigned gen = old / nloc;
    if (old + 1u == (gen + 1u) * nloc) {
      __builtin_amdgcn_fence(__ATOMIC_RELEASE, "agent");
      asm volatile("s_waitcnt vmcnt(0)" ::: "memory");
      const unsigned og = xb_add(&bar[XB_TOP], 1u);
      const unsigned tg = og / nx;
      if (og + 1u == (tg + 1u) * nx) xb_add(&bar[XB_TOPGEN], 1u);
      else XB_SPIN(xb_ld(&bar[XB_TOPGEN]) == tg, bar);
      __builtin_amdgcn_fence(__ATOMIC_ACQUIRE, "agent");
      xb_add(&bar[XB_XGEN(x)], 1u);
      asm volatile("s_waitcnt vmcnt(0)" ::: "memory");
    } else {
      XB_SPIN(xb_ld(&bar[XB_XGEN(x)]) == gen, bar);
      __builtin_amdgcn_fence(__ATOMIC_ACQUIRE, "agent");
      asm volatile("s_waitcnt vmcnt(0)" ::: "memory");
    }
  }
  __syncthreads();
}

#if MULTI_LAUNCH
extern __shared__ __attribute__((aligned(16))) char smem[];
template <int PH> __global__ void __launch_bounds__(NT, 2) phase_kernel(Params p, int layer) {
  run_phase(p, PH, layer, blockIdx.x, gridDim.x, smem);
}
template <int PH> static void launch_phase(const Params& p, int layer, hipStream_t stream) {
  (void)hipFuncSetAttribute((const void*)phase_kernel<PH>, hipFuncAttributeMaxDynamicSharedMemorySize, SMEM_BYTES);
  phase_kernel<PH><<<1024, NT, SMEM_BYTES, stream>>>(p, layer);
}
#else
extern __shared__ __attribute__((aligned(16))) char smem[];
__global__ void __launch_bounds__(NT, 2) mega_kernel(Params p) {
  cg::grid_group grid = cg::this_grid();
  const int bid = blockIdx.x, nb = gridDim.x;
  unsigned* bar = (unsigned*)(p.ws + OFF_BAR);
  volatile unsigned* st = (volatile unsigned*)(smem + SMEM_BYTES);
  if (threadIdx.x == 0) { st[0] = 0u; st[1] = 0u; }
  const unsigned xcc = xb_xcc_id();
  if (threadIdx.x == 0) (void)xb_add(&bar[XB_XCNT(xcc)], 1u);
  if (p.ws == nullptr) grid.sync();
  run_phase(p, PH_INIT, 0, bid, nb, smem);
  grid_barrier(bar, st, xcc, (unsigned)nb);
  for (int layer = 0; layer < 2; ++layer) {
    for (int ph = PH_NORM1; ph <= PH_FFN2; ++ph) {
#ifdef DUP_MASK
      const int reps = 1 + ((DUP_MASK >> ph) & 1);
#else
      const int reps = 1;
#endif
#pragma unroll 1
      for (int rep = 0; rep < reps; ++rep) {
        run_phase(p, ph, layer, bid, nb, smem, rep == reps - 1);
        grid_barrier(bar, st, xcc, (unsigned)nb);
      }
    }
  }
#ifdef EXTRA_SYNCS
#pragma unroll 1
  for (int i = 0; i < EXTRA_SYNCS; ++i) grid_barrier(bar, st, xcc, (unsigned)nb);
#endif
  run_phase(p, PH_FINAL, 1, bid, nb, smem);
}
#endif

extern "C" void kernel_launch(void* const* d_in, const int* in_sizes, int n_in, void* d_out, int out_size, void* d_ws, size_t ws_size,
                              hipStream_t stream) {
  Params p{};
  const float** pf = (const float**)&p;
  for (int i = 0; i < 23; ++i) pf[i] = (const float*)d_in[i];
  p.out = (float*)d_out;
  p.ws = (char*)d_ws;
#if MULTI_LAUNCH
  launch_phase<PH_INIT>(p, 0, stream);
  for (int layer = 0; layer < 2; ++layer) {
    launch_phase<PH_NORM1>(p, layer, stream); launch_phase<PH_INPROJ>(p, layer, stream); launch_phase<PH_PREP>(p, layer, stream);
    launch_phase<PH_MIX1>(p, layer, stream); launch_phase<PH_SCAN>(p, layer, stream); launch_phase<PH_S3>(p, layer, stream);
    launch_phase<PH_OUTPROJ>(p, layer, stream); launch_phase<PH_NORM2>(p, layer, stream); launch_phase<PH_FFN1>(p, layer, stream);
    launch_phase<PH_FFN2>(p, layer, stream);
  }
  launch_phase<PH_FINAL>(p, 1, stream);
#else
  static int grid_blocks = 0;
  if (!grid_blocks) {
    int dev = 0, cus = 0, per_cu = 0;
    (void)hipGetDevice(&dev);
    (void)hipDeviceGetAttribute(&cus, hipDeviceAttributeMultiprocessorCount, dev);
    (void)hipFuncSetAttribute((const void*)mega_kernel, hipFuncAttributeMaxDynamicSharedMemorySize, SMEM_BYTES + 16);
    (void)hipOccupancyMaxActiveBlocksPerMultiprocessor(&per_cu, mega_kernel, NT, SMEM_BYTES + 16);
    if (per_cu > 2) per_cu = 2;
    grid_blocks = cus * per_cu;
  }
  (void)hipMemsetAsync((char*)d_ws + OFF_BAR, 0, 64 * 256, stream);
  void* args[] = {&p};
  hipError_t e = hipLaunchCooperativeKernel((void*)mega_kernel, dim3(grid_blocks), dim3(NT), args, SMEM_BYTES + 16, stream);
  if (e != hipSuccess) fprintf(stderr, "cooperative launch failed: %s (grid %d)\n", hipGetErrorString(e), grid_blocks);
#endif
}
```

```cpp
#include <hip/hip_runtime.h>
#include <hip/hip_cooperative_groups.h>
#include <cstdio>
#include <cstdint>
namespace cg = cooperative_groups;

#ifndef MULTI_LAUNCH
#define MULTI_LAUNCH 0
#endif

#define DI __device__ __forceinline__
typedef unsigned short bf16_t;
typedef short bf16x8 __attribute__((ext_vector_type(8)));
typedef short bf16x4 __attribute__((ext_vector_type(4)));
typedef float f32x16 __attribute__((ext_vector_type(16)));
typedef float f32x4 __attribute__((ext_vector_type(4)));
typedef float f32x2 __attribute__((ext_vector_type(2)));
typedef unsigned u32x4 __attribute__((ext_vector_type(4)));
typedef unsigned u32x2 __attribute__((ext_vector_type(2)));
typedef __bf16 bf16v2 __attribute__((ext_vector_type(2)));

#define MFMA32(a, b, c) __builtin_amdgcn_mfma_f32_32x32x16_bf16((a), (b), (c), 0, 0, 0)
#define MFMA16(a, b, c) __builtin_amdgcn_mfma_f32_16x16x32_bf16((a), (b), (c), 0, 0, 0)

constexpr int L_ = 16384, LC_ = 256, T_ = 16640, DM = 1024, NIN = 2832, NINP = 2944, FH = 2816, NCH = 130;
constexpr int NT = 256;
constexpr float EPSF = 1e-6f;
constexpr float LOG2E = 1.4426950408889634f;
constexpr int SMEM_BYTES = 73728;

constexpr size_t al256(size_t x) { return (x + 255) & ~(size_t)255; }
constexpr size_t OFF_WIN = 0;
constexpr size_t OFF_WOUT = OFF_WIN + al256((size_t)NINP * DM * 2);
constexpr size_t OFF_WGU = OFF_WOUT + al256((size_t)DM * DM * 2);
constexpr size_t OFF_WD = OFF_WGU + al256((size_t)2 * FH * DM * 2);
constexpr size_t OFF_MOD = OFF_WD + al256((size_t)DM * FH * 2);
constexpr size_t OFF_ROPE = OFF_MOD + al256((size_t)2 * 2 * 6144 * 4);
constexpr size_t OFF_XC = OFF_ROPE + al256((size_t)256 * 16 * 8);
constexpr size_t OFF_A1 = OFF_XC + al256((size_t)LC_ * DM * 4);
constexpr size_t OFF_U = OFF_A1 + al256((size_t)T_ * DM * 2);
constexpr size_t OFF_DTRAW = OFF_U + al256((size_t)T_ * NIN * 2);
constexpr size_t OFF_DT = OFF_DTRAW + al256((size_t)T_ * 16 * 4);
constexpr size_t OFF_ACUM = OFF_DT + al256((size_t)T_ * 16 * 4);
constexpr size_t OFF_XBT = OFF_ACUM + al256((size_t)T_ * 16 * 4);
constexpr size_t OFF_BC = OFF_XBT + al256((size_t)NCH * 768 * 128 * 2);
constexpr size_t OFF_QG = OFF_BC + al256((size_t)T_ * 512 * 2);
constexpr size_t OFF_KG = OFF_QG + al256((size_t)T_ * 256 * 2);
constexpr size_t OFF_VGT = OFF_KG + al256((size_t)T_ * 128 * 2);
constexpr size_t OFF_VNT = OFF_VGT + al256((size_t)T_ * 128 * 2);
constexpr size_t OFF_ST = OFF_VNT + al256((size_t)T_ * 256 * 2);
constexpr size_t OFF_CDEC = OFF_ST + al256((size_t)16 * NCH * 8192 * 2);
constexpr size_t OFF_SSQ = OFF_CDEC + al256((size_t)16 * NCH * 4);
constexpr size_t OFF_BAR = OFF_SSQ + al256((size_t)T_ * 4);
constexpr size_t WS_TOTAL = OFF_BAR + 64 * 256;
static_assert(WS_TOTAL <= (size_t)256 * 1024 * 1024, "workspace too large");

struct Params {
  const float *x, *c, *ctx, *c_ctx, *mod_w, *mod_b, *norm_attn_w, *norm_ffn_w, *w_in, *na_rpb, *conv_w, *conv_b, *dt_bias, *a_log,
      *ssd_d, *ssd_norm_w, *q_norm_w, *k_norm_w, *w_out, *w_gate, *w_up, *w_down, *final_norm_w;
  float* out;
  char* ws;
};

DI unsigned pack2(float lo, float hi) { f32x2 v = {lo, hi}; return __builtin_bit_cast(unsigned, __builtin_convertvector(v, bf16v2)); }
DI bf16_t f2bf(float x) { return (bf16_t)(pack2(x, 0.f) & 0xffffu); }
DI float bf2f(bf16_t v) { return __uint_as_float(((unsigned)v) << 16); }
DI float bflo(unsigned u) { return __uint_as_float(u << 16); }
DI float bfhi(unsigned u) { return __uint_as_float(u & 0xffff0000u); }
DI int crow(int reg, int hh) { return (reg & 3) + 8 * (reg >> 2) + 4 * hh; }
DI float siluf(float x) { return x * __builtin_amdgcn_rcpf(1.f + __expf(-x)); }
DI f32x16 zero16() { f32x16 z; for (int i = 0; i < 16; ++i) z[i] = 0.f; return z; }
template <int S> DI bf16x8 pack8(const f32x16& x) {
  u32x4 p;
  p[0] = pack2(x[8 * S + 0], x[8 * S + 1]); p[1] = pack2(x[8 * S + 2], x[8 * S + 3]);
  p[2] = pack2(x[8 * S + 4], x[8 * S + 5]); p[3] = pack2(x[8 * S + 6], x[8 * S + 7]);
  return __builtin_bit_cast(bf16x8, p);
}
DI bf16x8 cat44(u32x2 lo, u32x2 hi) { u32x4 p = {lo[0], lo[1], hi[0], hi[1]}; return __builtin_bit_cast(bf16x8, p); }
DI float shx(float v, int mask, int lane) { return __int_as_float(__builtin_amdgcn_ds_bpermute((lane ^ mask) << 2, __float_as_int(v))); }
DI float wave_sum(float v, int lane) {
#pragma unroll
  for (int o = 32; o > 0; o >>= 1) v += shx(v, o, lane);
  return v;
}

DI void mod_item(int tix, const Params& p, int it, char* smem) {
  const int tid = tix, layer = it / 96, cg64 = it % 96, col = tid & 63, kq = tid >> 6;
  const float* W = p.mod_w + (size_t)layer * DM * 6144 + cg64 * 64 + col;
  float* sc = (float*)smem;
  float* red = sc + 2048;
  __syncthreads();
  for (int i = tid; i < 1024; i += NT) { sc[i] = siluf(p.c[i]); sc[1024 + i] = siluf(p.c_ctx[i]); }
  __syncthreads();
  float a0 = 0.f, a1 = 0.f;
#pragma unroll 1
  for (int k0 = kq * 256; k0 < kq * 256 + 256; k0 += 16) {
    float w[16];
#pragma unroll
    for (int j = 0; j < 16; ++j) w[j] = W[(size_t)(k0 + j) * 6144];
#pragma unroll
    for (int j = 0; j < 16; ++j) { a0 += sc[k0 + j] * w[j]; a1 += sc[1024 + k0 + j] * w[j]; }
  }
  red[(0 * 4 + kq) * 64 + col] = a0; red[(1 * 4 + kq) * 64 + col] = a1;
  __syncthreads();
  if (tid < 128) {
    const int src = tid >> 6;
    float s = red[(src * 4 + 0) * 64 + col] + red[(src * 4 + 1) * 64 + col] + red[(src * 4 + 2) * 64 + col] + red[(src * 4 + 3) * 64 + col];
    s += p.mod_b[layer * 6144 + cg64 * 64 + col];
    float* MOD = (float*)(p.ws + OFF_MOD);
    MOD[(layer * 2 + src) * 6144 + cg64 * 64 + col] = s;
  }
}
DI void rope_item(int tix, const Params& p, int it) {
  const int e = it * NT + tix;
  const int pos = e >> 4, j = e & 15;
  const double freq = exp2(-(double)j * (13.287712379549449 / 16.0));
  double rv = (double)pos * freq * 0.15915494309189535;
  rv -= floor(rv);
  const float fr = (float)rv;
  f32x2* R = (f32x2*)(p.ws + OFF_ROPE);
  f32x2 cs = {__builtin_amdgcn_cosf(fr), __builtin_amdgcn_sinf(fr)};
  R[e] = cs;
}

DI void wconv_tile(int tix, const float* __restrict__ src0, const float* __restrict__ src1, int ldsrc, int ncols_valid, bf16_t* __restrict__ dst, int K,
                   int nt, int kt, int mode, char* smem) {
  float* tile = (float*)smem;
  const int tid = tix, cn = tid & 63, rq = tid >> 6;
  __syncthreads();
  for (int i = 0; i < 16; ++i) {
    const int k = i * 4 + rq;
    float v;
    if (mode == 0) { const int n = nt * 64 + cn; v = (n < ncols_valid) ? src0[(size_t)(kt * 64 + k) * ldsrc + n] : 0.f; }
    else { const int unit = nt * 32 + (cn & 31); v = ((cn >> 5) ? src1 : src0)[(size_t)(kt * 64 + k) * ldsrc + unit]; }
    tile[k * 65 + cn] = v;
  }
  __syncthreads();
  for (int i = 0; i < 16; ++i) {
    const int n = i * 4 + rq, k = cn;
    dst[(size_t)(nt * 64 + n) * K + kt * 64 + k] = f2bf(tile[k * 65 + n]);
  }
}
constexpr int WC_IN = 46 * 16, WC_OUT = 16 * 16, WC_GU = 88 * 16, WC_D = 16 * 44, WC_TOTAL = WC_IN + WC_OUT + WC_GU + WC_D;
DI void wconv_item(int tix, const Params& p, int layer, int it, char* smem) {
  if (it < WC_IN) { wconv_tile(tix, p.w_in + (size_t)layer * DM * NIN, nullptr, NIN, NIN, (bf16_t*)(p.ws + OFF_WIN), DM, it / 16, it % 16, 0, smem); return; }
  it -= WC_IN;
  if (it < WC_OUT) { wconv_tile(tix, p.w_out + (size_t)layer * DM * DM, nullptr, DM, DM, (bf16_t*)(p.ws + OFF_WOUT), DM, it / 16, it % 16, 0, smem); return; }
  it -= WC_OUT;
  if (it < WC_GU) { wconv_tile(tix, p.w_gate + (size_t)layer * DM * FH, p.w_up + (size_t)layer * DM * FH, FH, FH, (bf16_t*)(p.ws + OFF_WGU), DM, it / 16, it % 16, 1, smem); return; }
  it -= WC_GU;
  wconv_tile(tix, p.w_down + (size_t)layer * FH * DM, nullptr, DM, DM, (bf16_t*)(p.ws + OFF_WD), FH, it / 44, it % 44, 0, smem);
}

DI void norm_item(int tix, const Params& p, int layer, int which, int it) {
  const int lane = tix & 63, wid = tix >> 6;
  const float* MOD = (const float*)(p.ws + OFF_MOD);
  const float* XC = (const float*)(p.ws + OFF_XC);
  bf16_t* A1 = (bf16_t*)(p.ws + OFF_A1);
  f32x4 v[2][4];
#pragma unroll
  for (int rr = 0; rr < 2; ++rr) {
    const int row = it * 8 + wid * 2 + rr;
    const float* src;
    if (row < L_) src = ((layer == 0 && which == 0) ? p.x : p.out) + (size_t)row * DM;
    else src = ((layer == 0 && which == 0) ? p.ctx : XC) + (size_t)(row - L_) * DM;
#pragma unroll
    for (int i = 0; i < 4; ++i) v[rr][i] = *(const f32x4*)(src + i * 256 + lane * 4);
  }
#pragma unroll
  for (int rr = 0; rr < 2; ++rr) {
    const int row = it * 8 + wid * 2 + rr;
    float ss = 0.f;
#pragma unroll
    for (int i = 0; i < 4; ++i) ss += v[rr][i][0] * v[rr][i][0] + v[rr][i][1] * v[rr][i][1] + v[rr][i][2] * v[rr][i][2] + v[rr][i][3] * v[rr][i][3];
    ss = wave_sum(ss, lane);
    const float rstd = rsqrtf(ss * (1.f / DM) + EPSF);
    if (which == 2) {
      float* dst = p.out + (size_t)row * DM;
#pragma unroll
      for (int i = 0; i < 4; ++i) {
        const f32x4 w = *(const f32x4*)(p.final_norm_w + i * 256 + lane * 4);
        f32x4 o; for (int j = 0; j < 4; ++j) o[j] = v[rr][i][j] * rstd * w[j];
        *(f32x4*)(dst + i * 256 + lane * 4) = o;
      }
    } else {
      const float* nw = (which == 0 ? p.norm_attn_w : p.norm_ffn_w) + layer * DM;
      const float* md = MOD + (layer * 2 + (row >= L_ ? 1 : 0)) * 6144 + (which == 0 ? 0 : 3 * DM);
#pragma unroll
      for (int i = 0; i < 4; ++i) {
        const int c = i * 256 + lane * 4;
        const f32x4 w = *(const f32x4*)(nw + c), sh = *(const f32x4*)(md + c), sc = *(const f32x4*)(md + DM + c);
        float o[4]; for (int j = 0; j < 4; ++j) o[j] = v[rr][i][j] * rstd * w[j] * (1.f + sc[j]) + sh[j];
        u32x2 pk = {pack2(o[0], o[1]), pack2(o[2], o[3])};
        *(u32x2*)(A1 + (size_t)row * DM + c) = pk;
      }
    }
  }
}

template <bool SCALE_A, bool NOLOAD = false, class Epi>
DI void gemm_tile(int tix, const float* __restrict__ SSQ, const bf16_t* __restrict__ A, int lda, const bf16_t* __restrict__ Bt, int ldb, int K, int m0, int n0, char* smem, const Epi& epi, int kbeg = 0) {
  const int tid = tix, lane = tid & 63, wid = tid >> 6, wr = wid >> 1, wc = wid & 1, fr = lane & 15, fq = lane >> 4;
  bf16_t* sbuf = (bf16_t*)smem;
  constexpr int STG = 2 * 128 * 72;
  f32x4 acc[4][4];
#pragma unroll
  for (int mi = 0; mi < 4; ++mi)
#pragma unroll
    for (int ni = 0; ni < 4; ++ni) acc[mi][ni] = (f32x4){0.f, 0.f, 0.f, 0.f};
  const int lrow = tid >> 3, lcol = (tid & 7) * 8;
  const bf16_t* ga = A + (size_t)(m0 + lrow) * lda + lcol + kbeg;
  const bf16_t* gb = Bt + (size_t)(n0 + lrow) * ldb + lcol + kbeg;
  float rs[4] = {1.f, 1.f, 1.f, 1.f};
  if (SCALE_A) {
#pragma unroll
    for (int i = 0; i < 4; ++i) rs[i] = rsqrtf(SSQ[m0 + lrow + 32 * i] * (1.f / 512.f) + EPSF);
  }
  u32x4 ra[4], rb[4];
  auto gload = [&](int k0) {
#pragma unroll
    for (int i = 0; i < 4; ++i) { ra[i] = *(const u32x4*)(ga + (size_t)(32 * i) * lda + k0); rb[i] = *(const u32x4*)(gb + (size_t)(32 * i) * ldb + k0); }
  };
  auto lstore = [&](int stage, int k0) {
    if (SCALE_A && kbeg + k0 >= 256 && kbeg + k0 < 768) {
#pragma unroll
      for (int i = 0; i < 4; ++i)
#pragma unroll
        for (int q = 0; q < 4; ++q) ra[i][q] = pack2(bflo(ra[i][q]) * rs[i], bfhi(ra[i][q]) * rs[i]);
    }
    bf16_t* sA = sbuf + stage * STG; bf16_t* sB = sA + 128 * 72;
#pragma unroll
    for (int i = 0; i < 4; ++i) { *(u32x4*)(sA + (lrow + 32 * i) * 72 + lcol) = ra[i]; *(u32x4*)(sB + (lrow + 32 * i) * 72 + lcol) = rb[i]; }
  };
  const int nk = K >> 6;
  gload(0);
  __syncthreads();
  lstore(0, 0);
  if (nk > 1) gload(64);
  __syncthreads();
  for (int kt = 0; kt < nk; ++kt) {
    const int cur = kt & 1;
    if (kt + 1 < nk) lstore(cur ^ 1, (kt + 1) * 64);
    if (!NOLOAD && kt + 2 < nk) gload((kt + 2) * 64);
    __builtin_amdgcn_sched_barrier(0);
    const bf16_t* sA = sbuf + cur * STG + (64 * wr + fr) * 72 + 8 * fq;
    const bf16_t* sB = sbuf + cur * STG + 128 * 72 + (64 * wc + fr) * 72 + 8 * fq;
#pragma unroll
    for (int ks = 0; ks < 2; ++ks) {
      bf16x8 a[4], b[4];
#pragma unroll
      for (int i = 0; i < 4; ++i) { a[i] = *(const bf16x8*)(sA + 16 * i * 72 + 32 * ks); b[i] = *(const bf16x8*)(sB + 16 * i * 72 + 32 * ks); }
#pragma unroll
      for (int mi = 0; mi < 4; ++mi)
#pragma unroll
        for (int ni = 0; ni < 4; ++ni) acc[mi][ni] = MFMA16(b[ni], a[mi], acc[mi][ni]);
    }
    __syncthreads();
  }
  epi(acc, m0 + 64 * wr, n0 + 64 * wc, fr, fq);
}

struct EpiInProj {
  bf16_t* U; float* DTRAW;
  DI void operator()(const f32x4 (&acc)[4][4], int mrow, int ncol, int fr, int fq) const {
#pragma unroll
    for (int mi = 0; mi < 4; ++mi) {
      const int row = mrow + 16 * mi + fr;
#pragma unroll
      for (int ni = 0; ni < 4; ++ni) {
        const int col = ncol + 16 * ni + 4 * fq;
        if (col < NIN) {
          u32x2 pk = {pack2(acc[mi][ni][0], acc[mi][ni][1]), pack2(acc[mi][ni][2], acc[mi][ni][3])};
          *(u32x2*)(U + (size_t)row * NIN + col) = pk;
          if (col >= 2304 && col < 2320) *(f32x4*)(DTRAW + row * 16 + col - 2304) = acc[mi][ni];
        }
      }
    }
  }
};
struct EpiResid {
  const float* old_lat; const float* old_ctx; float* new_lat; float* new_ctx; const float* gate_lat; const float* gate_ctx;
  DI void operator()(const f32x4 (&acc)[4][4], int mrow, int ncol, int fr, int fq) const {
#pragma unroll
    for (int mi = 0; mi < 4; ++mi) {
      const int row = mrow + 16 * mi + fr;
      const bool lat = row < L_;
      const float* op = lat ? old_lat + (size_t)row * DM : old_ctx + (size_t)(row - L_) * DM;
      float* np = lat ? new_lat + (size_t)row * DM : new_ctx + (size_t)(row - L_) * DM;
      const float* gp = lat ? gate_lat : gate_ctx;
#pragma unroll
      for (int ni = 0; ni < 4; ++ni) {
        const int col = ncol + 16 * ni + 4 * fq;
        const f32x4 o = *(const f32x4*)(op + col), gt = *(const f32x4*)(gp + col);
        *(f32x4*)(np + col) = o + gt * acc[mi][ni];
      }
    }
  }
};
struct EpiCtxAtomic {
  float* xc; const float* gate;
  DI void operator()(const f32x4 (&acc)[4][4], int mrow, int ncol, int fr, int fq) const {
#pragma unroll
    for (int mi = 0; mi < 4; ++mi) {
      float* np = xc + (size_t)(mrow + 16 * mi + fr - L_) * DM;
#pragma unroll
      for (int ni = 0; ni < 4; ++ni) {
        const int col = ncol + 16 * ni + 4 * fq;
        const f32x4 gt = *(const f32x4*)(gate + col);
#pragma unroll
        for (int j = 0; j < 4; ++j) atomicAdd(np + col + j, gt[j] * acc[mi][ni][j]);
      }
    }
  }
};
struct EpiSwiGLU {
  bf16_t* ACT;
  DI void operator()(const f32x4 (&acc)[4][4], int mrow, int ncol, int fr, int fq) const {
    const int unit0 = (ncol >> 1) + 4 * fq;
#pragma unroll
    for (int mi = 0; mi < 4; ++mi) {
      const int row = mrow + 16 * mi + fr;
#pragma unroll
      for (int ni = 0; ni < 2; ++ni) {
        float o[4];
#pragma unroll
        for (int j = 0; j < 4; ++j) o[j] = siluf(acc[mi][ni][j]) * acc[mi][ni + 2][j];
        u32x2 pk = {pack2(o[0], o[1]), pack2(o[2], o[3])};
        *(u32x2*)(ACT + (size_t)row * FH + unit0 + 16 * ni) = pk;
      }
    }
  }
};

template <bool SCALE_A, bool NOLOAD = false, class Epi>
DI void gemm_tile256(int tix, const float* __restrict__ SSQ, const bf16_t* __restrict__ A, int lda, const bf16_t* __restrict__ Bt, int ldb, int K, int m0, int n0, char* smem, const Epi& epi, int kbeg = 0, int scale_after = -1, bool kperm = false) {
  const int tid = tix, lane = tid & 63, wid = tid >> 6, wr = wid >> 1, wc = wid & 1, fr = lane & 15, fq = lane >> 4;
  bf16_t* sA = (bf16_t*)smem;
  bf16_t* sB = sA + 256 * 72;
  f32x4 acc[8][4];
#pragma unroll
  for (int mi = 0; mi < 8; ++mi)
#pragma unroll
    for (int ni = 0; ni < 4; ++ni) acc[mi][ni] = (f32x4){0.f, 0.f, 0.f, 0.f};
  const int lrow = tid >> 3, lcol = (tid & 7) * 8;
  const bf16_t* ga = A + (size_t)(m0 + lrow) * lda + lcol + kbeg;
  const bf16_t* gb = Bt + (size_t)(n0 + lrow) * ldb + lcol + kbeg;
  u32x4 ra[8], rb[4];
  auto gload = [&](int k0) {
#pragma unroll
    for (int i = 0; i < 8; ++i) ra[i] = *(const u32x4*)(ga + (size_t)(32 * i) * lda + k0);
#pragma unroll
    for (int i = 0; i < 4; ++i) rb[i] = *(const u32x4*)(gb + (size_t)(32 * i) * ldb + k0);
  };
  auto lstore = [&](int k0) {
#pragma unroll
    for (int i = 0; i < 8; ++i) *(u32x4*)(sA + (lrow + 32 * i) * 72 + lcol) = ra[i];
#pragma unroll
    for (int i = 0; i < 4; ++i) *(u32x4*)(sB + (lrow + 32 * i) * 72 + lcol) = rb[i];
  };
  const int nk = K >> 6;
  auto kof = [&](int kt) -> int { return kperm ? (kt < 8 ? 256 + 64 * kt : (kt < 12 ? 64 * (kt - 8) : 768 + 64 * (kt - 12))) : 64 * kt; };
  gload(kof(0));
  for (int kt = 0; kt < nk; ++kt) {
    __syncthreads();
    lstore(kof(kt));
    __syncthreads();
    if (!NOLOAD && kt + 1 < nk) gload(kof(kt + 1));
    const bf16_t* pA = sA + (128 * wr + fr) * 72 + 8 * fq;
    const bf16_t* pB = sB + (64 * wc + fr) * 72 + 8 * fq;
#pragma unroll
    for (int ks = 0; ks < 2; ++ks) {
      bf16x8 b[4];
#pragma unroll
      for (int i = 0; i < 4; ++i) b[i] = *(const bf16x8*)(pB + 16 * i * 72 + 32 * ks);
#pragma unroll
      for (int mh = 0; mh < 4; ++mh) {
        bf16x8 a[2];
#pragma unroll
        for (int i = 0; i < 2; ++i) a[i] = *(const bf16x8*)(pA + 16 * (2 * mh + i) * 72 + 32 * ks);
#pragma unroll
        for (int mi = 0; mi < 2; ++mi)
#pragma unroll
          for (int ni = 0; ni < 4; ++ni) acc[2 * mh + mi][ni] = MFMA16(b[ni], a[mi], acc[2 * mh + mi][ni]);
      }
    }
    if (SCALE_A && kt == scale_after) {
#pragma unroll
      for (int mi = 0; mi < 8; ++mi) {
        const float rs = rsqrtf(SSQ[m0 + 128 * wr + 16 * mi + fr] * (1.f / 512.f) + EPSF);
#pragma unroll
        for (int ni = 0; ni < 4; ++ni) acc[mi][ni] = acc[mi][ni] * rs;
      }
    }
  }
  epi(acc, m0 + 128 * wr, n0 + 64 * wc, fr, fq);
}

struct Epi256InProj {
  bf16_t* U; float* DTRAW;
  DI void operator()(const f32x4 (&acc)[8][4], int mrow, int ncol, int fr, int fq) const {
#pragma unroll
    for (int mi = 0; mi < 8; ++mi) {
      const int row = mrow + 16 * mi + fr;
#pragma unroll
      for (int ni = 0; ni < 4; ++ni) {
        const int col = ncol + 16 * ni + 4 * fq;
        if (col < NIN) {
          u32x2 pk = {pack2(acc[mi][ni][0], acc[mi][ni][1]), pack2(acc[mi][ni][2], acc[mi][ni][3])};
          *(u32x2*)(U + (size_t)row * NIN + col) = pk;
          if (col >= 2304 && col < 2320) *(f32x4*)(DTRAW + row * 16 + col - 2304) = acc[mi][ni];
        }
      }
      __builtin_amdgcn_sched_barrier(0);
    }
  }
};
struct Epi256Resid {
  const float* old_lat; float* new_lat; const float* gate_lat;
  DI void operator()(const f32x4 (&acc)[8][4], int mrow, int ncol, int fr, int fq) const {
#pragma unroll
    for (int mi = 0; mi < 8; ++mi) {
      const int row = mrow + 16 * mi + fr;
      const float* op = old_lat + (size_t)row * DM;
      float* np = new_lat + (size_t)row * DM;
#pragma unroll
      for (int ni = 0; ni < 4; ++ni) {
        const int col = ncol + 16 * ni + 4 * fq;
        const f32x4 o = *(const f32x4*)(op + col), gt = *(const f32x4*)(gate_lat + col);
        *(f32x4*)(np + col) = o + gt * acc[mi][ni];
      }
      __builtin_amdgcn_sched_barrier(0);
    }
  }
};
struct Epi256CtxAtomic {
  float* xc; const float* gate;
  DI void operator()(const f32x4 (&acc)[8][4], int mrow, int ncol, int fr, int fq) const {
#pragma unroll
    for (int mi = 0; mi < 8; ++mi) {
      float* np = xc + (size_t)(mrow + 16 * mi + fr - L_) * DM;
#pragma unroll
      for (int ni = 0; ni < 4; ++ni) {
        const int col = ncol + 16 * ni + 4 * fq;
        const f32x4 gt = *(const f32x4*)(gate + col);
#pragma unroll
        for (int j = 0; j < 4; ++j) atomicAdd(np + col + j, gt[j] * acc[mi][ni][j]);
      }
      __builtin_amdgcn_sched_barrier(0);
    }
  }
};
struct Epi256SwiGLU {
  bf16_t* ACT;
  DI void operator()(const f32x4 (&acc)[8][4], int mrow, int ncol, int fr, int fq) const {
    const int unit0 = (ncol >> 1) + 4 * fq;
#pragma unroll
    for (int mi = 0; mi < 8; ++mi) {
      const int row = mrow + 16 * mi + fr;
#pragma unroll
      for (int ni = 0; ni < 2; ++ni) {
        float o[4];
#pragma unroll
        for (int j = 0; j < 4; ++j) o[j] = siluf(acc[mi][ni][j]) * acc[mi][ni + 2][j];
        u32x2 pk = {pack2(o[0], o[1]), pack2(o[2], o[3])};
        *(u32x2*)(ACT + (size_t)row * FH + unit0 + 16 * ni) = pk;
      }
      __builtin_amdgcn_sched_barrier(0);
    }
  }
};

DI void conv_item(int tix, const Params& p, int layer, int it) {
  const int tb = it >> 2, cgp = it & 3;
  const int lane = tix & 63, tg = tix >> 6;
  const bf16_t* U = (const bf16_t*)(p.ws + OFF_U);
  const int c = cgp * 256 + lane * 4;
  const int row0 = tb * 64 + tg * 16;
  const int seq_lo = (row0 < L_) ? 0 : L_, seq_hi = (row0 < L_) ? L_ : T_;
  f32x4 w[5];
#pragma unroll
  for (int j = 0; j < 5; ++j) w[j] = *(const f32x4*)(p.conv_w + ((size_t)layer * 5 + j) * 1024 + c);
  const f32x4 bias = *(const f32x4*)(p.conv_b + layer * 1024 + c);
  u32x2 xr[20];
#pragma unroll
  for (int i = 0; i < 20; ++i) {
    const int row = row0 + i - 2;
    u32x2 z = {0u, 0u};
    xr[i] = (row >= seq_lo && row < seq_hi) ? *(const u32x2*)(U + (size_t)row * NIN + 1280 + c) : z;
  }
  unsigned o[4][8];
  bf16_t* BC = (bf16_t*)(p.ws + OFF_BC);
#pragma unroll
  for (int i = 0; i < 16; i += 2) {
    float y0[4], y1[4];
#pragma unroll
    for (int q = 0; q < 4; ++q) { y0[q] = bias[q]; y1[q] = bias[q]; }
#pragma unroll
    for (int j = 0; j < 5; ++j) {
      const u32x2 a = xr[i + j], b = xr[i + 1 + j];
      y0[0] += w[j][0] * bflo(a[0]); y0[1] += w[j][1] * bfhi(a[0]); y0[2] += w[j][2] * bflo(a[1]); y0[3] += w[j][3] * bfhi(a[1]);
      y1[0] += w[j][0] * bflo(b[0]); y1[1] += w[j][1] * bfhi(b[0]); y1[2] += w[j][2] * bflo(b[1]); y1[3] += w[j][3] * bfhi(b[1]);
    }
#pragma unroll
    for (int q = 0; q < 4; ++q) { y0[q] = siluf(y0[q]); y1[q] = siluf(y1[q]); o[q][i >> 1] = pack2(y0[q], y1[q]); }
    if (cgp >= 2) {
      u32x2 t0 = {pack2(y0[0], y0[1]), pack2(y0[2], y0[3])}, t1 = {pack2(y1[0], y1[1]), pack2(y1[2], y1[3])};
      *(u32x2*)(BC + (size_t)(row0 + i) * 512 + (c - 512)) = t0;
      *(u32x2*)(BC + (size_t)(row0 + i + 1) * 512 + (c - 512)) = t1;
    }
  }
  if (cgp < 3) {
    bf16_t* XBT = (bf16_t*)(p.ws + OFF_XBT);
    const int gc = row0 >> 7, tl = row0 & 127;
#pragma unroll
    for (int q = 0; q < 4; ++q) {
      u32x4 lo = {o[q][0], o[q][1], o[q][2], o[q][3]}, hi = {o[q][4], o[q][5], o[q][6], o[q][7]};
      u32x4* d = (u32x4*)(XBT + ((size_t)gc * 768 + c + q) * 128 + tl);
      d[0] = lo; d[1] = hi;
    }
  }
}

DI void dt_item(int tix, const Params& p, int layer, int gc, char* smem) {
  const int tid = tix, lane = tid & 63, wid = tid >> 6;
  const float* DTRAW = (const float*)(p.ws + OFF_DTRAW);
  float* DT = (float*)(p.ws + OFF_DT);
  float* AC = (float*)(p.ws + OFF_ACUM);
  if (tid < 128) ((float*)(p.ws + OFF_SSQ))[gc * 128 + tid] = 0.f;
#pragma unroll
  for (int ci = 0; ci < 4; ++ci) {
    const int col = wid * 4 + ci;
    const int d = col >> 3;
    const float bias = p.dt_bias[layer * 16 + col];
    const float a = -__expf(p.a_log[layer * 16 + col]);
    const int i0 = 2 * lane, i1 = 2 * lane + 1;
    const int t0 = d ? 127 - i0 : i0, t1 = d ? 127 - i1 : i1;
    const size_t r0 = (size_t)(gc * 128 + t0) * 16 + col, r1 = (size_t)(gc * 128 + t1) * 16 + col;
    float x0 = DTRAW[r0] + bias, x1 = DTRAW[r1] + bias;
    const float dt0 = x0 > 20.f ? x0 : log1pf(__expf(x0));
    const float dt1 = x1 > 20.f ? x1 : log1pf(__expf(x1));
    const float v0 = dt0 * a, v1 = dt1 * a;
    float s = v0 + v1, inc = s;
    for (int o = 1; o < 64; o <<= 1) { const float n = __int_as_float(__builtin_amdgcn_ds_bpermute((lane - o) << 2, __float_as_int(inc))); if (lane >= o) inc += n; }
    const float excl = inc - s;
    DT[r0] = dt0; DT[r1] = dt1;
    AC[r0] = excl + v0; AC[r1] = excl + v0 + v1;
  }
}

DI void qk_item(int tix, const Params& p, int layer, int it) {
  const int rid2 = it * NT + tix;
  const int half = rid2 & 1, rowid = rid2 >> 1;
  const int tok = rowid / 6, hsel = rowid - tok * 6;
  const bf16_t* U = (const bf16_t*)(p.ws + OFF_U);
  const f32x2* R = (const f32x2*)(p.ws + OFF_ROPE);
  const u32x4* src = (const u32x4*)(U + (size_t)tok * NIN + 2320 + hsel * 64 + 32 * half);
  float x[32];
  float ss = 0.f;
#pragma unroll
  for (int i = 0; i < 4; ++i) {
    const u32x4 v = src[i];
#pragma unroll
    for (int q = 0; q < 4; ++q) { x[8 * i + 2 * q] = bflo(v[q]); x[8 * i + 2 * q + 1] = bfhi(v[q]); }
  }
#pragma unroll
  for (int i = 0; i < 32; ++i) ss += x[i] * x[i];
  ss += shx(ss, 1, tix & 63);
  const float rstd = rsqrtf(ss * (1.f / 64.f) + EPSF);
  const f32x4* nw = (const f32x4*)((hsel < 4 ? p.q_norm_w : p.k_norm_w) + layer * 64 + 32 * half);
#pragma unroll
  for (int i = 0; i < 8; ++i) {
    const f32x4 w = nw[i];
#pragma unroll
    for (int j = 0; j < 4; ++j) x[4 * i + j] = x[4 * i + j] * rstd * w[j];
  }
  if (tok < L_) {
    const int pos = half ? (tok & 63) : (tok >> 6);
#pragma unroll
    for (int j = 0; j < 16; ++j) {
      const f32x2 cs = R[pos * 16 + j];
      const float a = x[j], b = x[16 + j];
      x[j] = a * cs[0] - b * cs[1];
      x[16 + j] = b * cs[0] + a * cs[1];
    }
  }
  const float sc = hsel < 4 ? 0.125f * LOG2E : 1.f;
  u32x4* dst = (hsel < 4) ? (u32x4*)((bf16_t*)(p.ws + OFF_QG) + (size_t)tok * 256 + hsel * 64 + 32 * half)
                          : (u32x4*)((bf16_t*)(p.ws + OFF_KG) + (size_t)tok * 128 + (hsel - 4) * 64 + 32 * half);
#pragma unroll
  for (int i = 0; i < 4; ++i) {
    u32x4 o;
#pragma unroll
    for (int q = 0; q < 4; ++q) o[q] = pack2(x[8 * i + 2 * q] * sc, x[8 * i + 2 * q + 1] * sc);
    dst[i] = o;
  }
}

DI void vtr_item(int tix, const Params& p, int it) {
  const bf16_t* U = (const bf16_t*)(p.ws + OFF_U);
  int row0, c, col0; bf16_t* dst;
  if (it < 260) { row0 = it * 64 + (tix >> 6) * 16; c = (tix & 63) * 4; col0 = 512; dst = (bf16_t*)(p.ws + OFF_VNT); }
  else { row0 = (it - 260) * 128 + (tix >> 5) * 16; c = (tix & 31) * 4; col0 = 2320 + 384; dst = (bf16_t*)(p.ws + OFF_VGT); }
  u32x2 xr[16];
#pragma unroll
  for (int i = 0; i < 16; ++i) xr[i] = *(const u32x2*)(U + (size_t)(row0 + i) * NIN + col0 + c);
#pragma unroll
  for (int q = 0; q < 4; ++q) {
    unsigned o[8];
#pragma unroll
    for (int i = 0; i < 8; ++i) {
      const unsigned a = xr[2 * i][q >> 1], b = xr[2 * i + 1][q >> 1];
      o[i] = (q & 1) ? ((a >> 16) | (b & 0xffff0000u)) : ((a & 0xffffu) | (b << 16));
    }
    u32x4 lo = {o[0], o[1], o[2], o[3]}, hi = {o[4], o[5], o[6], o[7]};
    u32x4* d = (u32x4*)(dst + (size_t)(c + q) * T_ + row0);
    d[0] = lo; d[1] = hi;
  }
}

struct AttnState { f32x16 o[2]; float m, l; };

template <class KF, class VF, class SF>
DI void attn_tile(AttnState& st, int lane, bool first, float cinv, const bf16x8 (&qf)[4], const KF& kf, const VF& vf, const SF& sf) {
  f32x16 s[2];
  const float init = first ? 0.f : -st.m * cinv;
#pragma unroll
  for (int ks = 0; ks < 2; ++ks) {
#pragma unroll
    for (int i = 0; i < 16; ++i) s[ks][i] = init;
#pragma unroll
    for (int kk = 0; kk < 4; ++kk) s[ks] = MFMA32(kf(ks, kk), qf[kk], s[ks]);
  }
  sf(s);
  if (first) {
    float mx = fmaxf(s[0][0], s[1][0]);
#pragma unroll
    for (int i = 1; i < 16; ++i) mx = fmaxf(mx, fmaxf(s[0][i], s[1][i]));
    mx = fmaxf(mx, shx(mx, 32, lane));
    if (mx == -INFINITY) mx = 0.f;
    st.m = mx;
#pragma unroll
    for (int i = 0; i < 16; ++i) { s[0][i] -= mx; s[1][i] -= mx; }
  }
  float sum = 0.f;
#pragma unroll
  for (int ks = 0; ks < 2; ++ks)
#pragma unroll
    for (int i = 0; i < 16; ++i) { const float pv = __builtin_amdgcn_exp2f(s[ks][i]); s[ks][i] = pv; sum += pv; }
  sum += shx(sum, 32, lane);
  if (__any(sum > 65536.f)) {
    const float delta = sum > 65536.f ? ceilf(__log2f(sum)) : 0.f;
    const float sc = __builtin_amdgcn_exp2f(-delta);
    st.m += delta; st.l *= sc; sum *= sc;
#pragma unroll
    for (int i = 0; i < 16; ++i) { s[0][i] *= sc; s[1][i] *= sc; st.o[0][i] *= sc; st.o[1][i] *= sc; }
  }
  st.l += sum;
#pragma unroll
  for (int ks = 0; ks < 2; ++ks) {
    const bf16x8 p0 = pack8<0>(s[ks]), p1 = pack8<1>(s[ks]);
#pragma unroll
    for (int dt = 0; dt < 2; ++dt) {
      st.o[dt] = MFMA32(vf(dt, ks, 0), p0, st.o[dt]);
      st.o[dt] = MFMA32(vf(dt, ks, 1), p1, st.o[dt]);
    }
  }
}
DI void attn_store(const AttnState& st, bf16_t* __restrict__ dst  , int hh) {
  const float inv = 1.f / st.l;
#pragma unroll
  for (int dt = 0; dt < 2; ++dt)
#pragma unroll
    for (int g = 0; g < 4; ++g) {
      u32x2 pk = {pack2(st.o[dt][4 * g] * inv, st.o[dt][4 * g + 1] * inv), pack2(st.o[dt][4 * g + 2] * inv, st.o[dt][4 * g + 3] * inv)};
      *(u32x2*)(dst + 32 * dt + 8 * g + 4 * hh) = pk;
    }
}

DI void gqa_item(int tix, const Params& p, int qrow0, int g, int kt0, int kt1, char* smem) {
  const int tid = tix, lane = tid & 63, wid = tid >> 6, r = lane & 31, hh = lane >> 5;
  const int head = 2 * g + (wid >> 1), qsub = wid & 1;
  const bf16_t* QG = (const bf16_t*)(p.ws + OFF_QG);
  const bf16_t* KG = (const bf16_t*)(p.ws + OFF_KG);
  const bf16_t* VGT = (const bf16_t*)(p.ws + OFF_VGT);
  bf16_t* Y = (bf16_t*)(p.ws + OFF_A1);
  bf16_t* sbuf = (bf16_t*)smem;
  constexpr int STG = 64 * 72 + 64 * 68;
  const int qrow = qrow0 + 32 * qsub + r;
  bf16x8 qf[4];
#pragma unroll
  for (int kk = 0; kk < 4; ++kk) qf[kk] = *(const bf16x8*)(QG + (size_t)qrow * 256 + head * 64 + 16 * kk + 8 * hh);
  AttnState st; st.o[0] = zero16(); st.o[1] = zero16(); st.m = 0.f; st.l = 0.f;
  const int lrow = tid >> 3, lcol = (tid & 7) * 8;
  const bf16_t* gk = KG + (size_t)lrow * 128 + g * 64 + lcol;
  const bf16_t* gv = VGT + (size_t)(g * 64 + lrow) * T_ + lcol;
  u32x4 rk0[2], rv0[2], rk1[2], rv1[2];
  auto gload = [&](int kt, u32x4 (&rk)[2], u32x4 (&rv)[2]) {
    if (kt < kt1) {
      const size_t key0 = (size_t)kt * 64;
      rk[0] = *(const u32x4*)(gk + key0 * 128); rk[1] = *(const u32x4*)(gk + (key0 + 32) * 128);
      rv[0] = *(const u32x4*)(gv + key0); rv[1] = *(const u32x4*)(gv + (size_t)32 * T_ + key0);
    }
  };
  auto lstore = [&](int stage, const u32x4 (&rk)[2], const u32x4 (&rv)[2]) {
    bf16_t* sK = sbuf + stage * STG; bf16_t* sV = sK + 64 * 72;
    *(u32x4*)(sK + lrow * 72 + lcol) = rk[0]; *(u32x4*)(sK + (lrow + 32) * 72 + lcol) = rk[1];
    u32x2 a = {rv[0][0], rv[0][1]}, b = {rv[0][2], rv[0][3]}, c = {rv[1][0], rv[1][1]}, d = {rv[1][2], rv[1][3]};
    *(u32x2*)(sV + lrow * 68 + lcol) = a; *(u32x2*)(sV + lrow * 68 + lcol + 4) = b;
    *(u32x2*)(sV + (lrow + 32) * 68 + lcol) = c; *(u32x2*)(sV + (lrow + 32) * 68 + lcol + 4) = d;
  };
  auto compute = [&](int stage, bool first) {
    const bf16_t* sK = sbuf + stage * STG; const bf16_t* sV = sK + 64 * 72;
    auto kf = [&](int ks, int kk) -> bf16x8 { return *(const bf16x8*)(sK + (32 * ks + r) * 72 + 16 * kk + 8 * hh); };
    auto vf = [&](int dt, int ks, int step) -> bf16x8 {
      const bf16_t* b = sV + (32 * dt + r) * 68 + 32 * ks + 16 * step + 4 * hh;
      return cat44(*(const u32x2*)b, *(const u32x2*)(b + 8));
    };
    auto sf = [&](f32x16 (&sx)[2]) {};
    attn_tile(st, lane, first, 1.f, qf, kf, vf, sf);
  };
  gload(kt0, rk0, rv0); gload(kt0 + 1, rk1, rv1);
  __syncthreads();
  lstore(0, rk0, rv0);
  gload(kt0 + 2, rk0, rv0);
  __syncthreads();
  for (int kt = kt0; kt < kt1; kt += 2) {
    lstore(1, rk1, rv1);
    gload(kt + 3, rk1, rv1);
    __builtin_amdgcn_sched_barrier(0);
    compute(0, kt == kt0);
    __syncthreads();
    if (kt + 2 < kt1) lstore(0, rk0, rv0);
    gload(kt + 4, rk0, rv0);
    __builtin_amdgcn_sched_barrier(0);
    compute(1, false);
    __syncthreads();
  }
  attn_store(st, Y + (size_t)qrow * DM + 768 + head * 64, hh);
}

DI void na_item(int tix, const Params& p, int layer, int rowidx, int hp, bool is_ctx, char* smem) {
  const int tid = tix, lane = tid & 63, wid = tid >> 6, r = lane & 31, hh = lane >> 5;
  const int head = 2 * hp + (wid >> 1), qsub = wid & 1;
  const bf16_t* U = (const bf16_t*)(p.ws + OFF_U);
  const bf16_t* VNT = (const bf16_t*)(p.ws + OFF_VNT);
  bf16_t* Y = (bf16_t*)(p.ws + OFF_A1);
  float* srpb = (float*)smem;
  __syncthreads();
  for (int i = tid; i < 2 * 465; i += NT) srpb[i] = p.na_rpb[((size_t)layer * 4 + 2 * hp) * 465 + i] * LOG2E;
  __syncthreads();
  const float* myrpb = srpb + (wid >> 1) * 465;
  const int qc = 32 * qsub + r;
  const int qrow = (is_ctx ? L_ + rowidx * 64 : rowidx * 64) + qc;
  bf16x8 qf[4];
#pragma unroll
  for (int kk = 0; kk < 4; ++kk) qf[kk] = *(const bf16x8*)(U + (size_t)qrow * NIN + head * 64 + 16 * kk + 8 * hh);
  AttnState st; st.o[0] = zero16(); st.o[1] = zero16(); st.m = 0.f; st.l = 0.f;
  const float c1 = 0.125f * LOG2E;
  const int r_start = min(max(rowidx - 4, 0), 248);
  const int cs = min(max(qc - 8, 0), 48);
  const int ntile = is_ctx ? 4 : 12;
  auto tok_of = [&](int t) -> int { const bool w = (!is_ctx) && (t < 8); return w ? (r_start + t) * 64 : L_ + (is_ctx ? t : t - 8) * 64; };
  bf16x8 kreg[8], kregn[8];
  auto ldK = [&](int t, bf16x8 (&kr)[8]) {
    const bf16_t* kb = U + (size_t)tok_of(t) * NIN + 256 + head * 64 + 8 * hh;
#pragma unroll
    for (int ks = 0; ks < 2; ++ks)
#pragma unroll
      for (int kk = 0; kk < 4; ++kk) kr[ks * 4 + kk] = *(const bf16x8*)(kb + (size_t)(32 * ks + r) * NIN + 16 * kk);
  };
  ldK(0, kreg);
#pragma unroll 1
  for (int t = 0; t < ntile; ++t) {
    const bool win = (!is_ctx) && (t < 8);
    const int tok0 = tok_of(t);
    const bf16_t* vb = VNT + (size_t)(head * 64) * T_ + tok0 + 4 * hh;
    u32x2 vreg[32];
#pragma unroll
    for (int dt = 0; dt < 2; ++dt)
#pragma unroll
      for (int ks = 0; ks < 2; ++ks)
#pragma unroll
        for (int step = 0; step < 2; ++step) {
          const bf16_t* b = vb + (size_t)(32 * dt + r) * T_ + 32 * ks + 16 * step;
          vreg[((dt * 2 + ks) * 2 + step) * 2] = *(const u32x2*)b; vreg[((dt * 2 + ks) * 2 + step) * 2 + 1] = *(const u32x2*)(b + 8);
        }
    if (t + 1 < ntile) ldK(t + 1, kregn);
    __builtin_amdgcn_sched_barrier(0);
    auto kf = [&](int ks, int kk) -> bf16x8 { return kreg[ks * 4 + kk]; };
    auto vf = [&](int dt, int ks, int step) -> bf16x8 { return cat44(vreg[((dt * 2 + ks) * 2 + step) * 2], vreg[((dt * 2 + ks) * 2 + step) * 2 + 1]); };
    const float* rp = myrpb + (r_start + t - rowidx + 7) * 31 + 15 - qc;
    auto sf = [&](f32x16 (&s)[2]) {
#pragma unroll
      for (int ks = 0; ks < 2; ++ks)
#pragma unroll
        for (int i = 0; i < 16; ++i) {
          const int kc = 32 * ks + crow(i, hh);
          if (win) {
            const bool ok = (kc >= cs) && (kc < cs + 16);
            s[ks][i] = ok ? (s[ks][i] * c1 + rp[ok ? kc : qc]) : -INFINITY;
          } else s[ks][i] = s[ks][i] * c1;
        }
    };
    attn_tile(st, lane, t == 0, 1.f / c1, qf, kf, vf, sf);
    if (t + 1 < ntile) {
#pragma unroll
      for (int j = 0; j < 8; ++j) kreg[j] = kregn[j];
    }
  }
  attn_store(st, Y + (size_t)qrow * DM + head * 64, hh);
}

DI void ssd_s1_item(int tix, const Params& p, int gc, int h, char* smem) {
  const int tid = tix, lane = tid & 63, wid = tid >> 6, r = lane & 31, hh = lane >> 5;
  const float* DT = (const float*)(p.ws + OFF_DT);
  const float* AC = (const float*)(p.ws + OFF_ACUM);
  float* CDEC = (float*)(p.ws + OFF_CDEC);
  const bf16_t* XBT = (const bf16_t*)(p.ws + OFF_XBT) + (size_t)gc * 768 * 128;
  bf16_t* ST = (bf16_t*)(p.ws + OFF_ST);
  float* sw = (float*)smem;
  __syncthreads();
  {
    const int d = tid >> 7, t = tid & 127, col = d * 8 + h;
    const float tot = AC[(size_t)(gc * 128 + (d ? 0 : 127)) * 16 + col];
    const float ac = AC[(size_t)(gc * 128 + t) * 16 + col], dt = DT[(size_t)(gc * 128 + t) * 16 + col];
    sw[d * 128 + t] = __expf(tot - ac) * dt;
    if (t == 0) CDEC[(d * 8 + h) * NCH + gc] = __expf(tot);
  }
  __syncthreads();
  const int g = h >> 2;
  f32x16 acc[2][2];
  acc[0][0] = zero16(); acc[0][1] = zero16(); acc[1][0] = zero16(); acc[1][1] = zero16();
#pragma unroll
  for (int kk = 0; kk < 8; ++kk) {
    const int kb = 16 * kk + 8 * hh;
    const bf16x8 bfrag = *(const bf16x8*)(XBT + (size_t)(512 + g * 128 + 32 * wid + r) * 128 + kb);
    float wf[8], wb[8];
#pragma unroll
    for (int j = 0; j < 8; ++j) { wf[j] = sw[kb + j]; wb[j] = sw[128 + kb + j]; }
#pragma unroll
    for (int mt = 0; mt < 2; ++mt) {
      const u32x4 xr = *(const u32x4*)(XBT + (size_t)(h * 64 + 32 * mt + r) * 128 + kb);
      u32x4 af, ab;
#pragma unroll
      for (int q = 0; q < 4; ++q) {
        const float lo = bflo(xr[q]), hi = bfhi(xr[q]);
        af[q] = pack2(lo * wf[2 * q], hi * wf[2 * q + 1]);
        ab[q] = pack2(lo * wb[2 * q], hi * wb[2 * q + 1]);
      }
      acc[0][mt] = MFMA32(bfrag, __builtin_bit_cast(bf16x8, af), acc[0][mt]);
      acc[1][mt] = MFMA32(bfrag, __builtin_bit_cast(bf16x8, ab), acc[1][mt]);
    }
  }
#pragma unroll
  for (int d = 0; d < 2; ++d)
#pragma unroll
    for (int mt = 0; mt < 2; ++mt)
#pragma unroll
      for (int q4 = 0; q4 < 4; ++q4) {
        const int pp = 32 * mt + r, n = 32 * wid + 8 * q4 + 4 * hh;
        u32x2 pk = {pack2(acc[d][mt][4 * q4], acc[d][mt][4 * q4 + 1]), pack2(acc[d][mt][4 * q4 + 2], acc[d][mt][4 * q4 + 3])};
        *(u32x2*)(ST + ((size_t)(d * 8 + h) * NCH + gc) * 8192 + pp * 128 + n) = pk;
      }
}

DI void ssd_scan_item(int tix, const Params& p, int it) {
  const int e2 = it * NT + tix;
  const int dh = e2 >> 12, within = e2 & 4095, d = dh >> 3;
  unsigned* ST = (unsigned*)(p.ws + OFF_ST) + (size_t)dh * NCH * 4096 + within;
  const float* CDEC = (const float*)(p.ws + OFF_CDEC) + dh * NCH;
  float r0 = 0.f, r1 = 0.f;
  for (int b = 0; b < 3; ++b) {
    unsigned v[44]; float dec[44];
#pragma unroll
    for (int j = 0; j < 44; ++j) {
      const int i = b * 44 + j;
      if (i < NCH) {
        const int gc = d ? (129 - i) : (i < 2 ? 128 + i : i - 2);
        v[j] = ST[(size_t)gc * 4096]; dec[j] = CDEC[gc];
      }
    }
#pragma unroll
    for (int j = 0; j < 44; ++j) {
      const int i = b * 44 + j;
      if (i < NCH) {
        const int gc = d ? (129 - i) : (i < 2 ? 128 + i : i - 2);
        ST[(size_t)gc * 4096] = pack2(r0, r1);
        r0 = dec[j] * r0 + bflo(v[j]); r1 = dec[j] * r1 + bfhi(v[j]);
      }
    }
  }
}

DI void ssd_s3_item(int tix, const Params& p, int layer, int gc, int tq, int g, char* smem, bool do_atomic) {
  const int tid = tix, lane = tid & 63, wid = tid >> 6, r = lane & 31, hh = lane >> 5;
  const float* DT = (const float*)(p.ws + OFF_DT);
  const float* AC = (const float*)(p.ws + OFF_ACUM);
  const bf16_t* XBT = (const bf16_t*)(p.ws + OFF_XBT) + (size_t)gc * 768 * 128;
  const bf16_t* BC = (const bf16_t*)(p.ws + OFF_BC) + (size_t)gc * 128 * 512;
  const bf16_t* ST = (const bf16_t*)(p.ws + OFF_ST);
  const bf16_t* U = (const bf16_t*)(p.ws + OFF_U);
  bf16_t* Y = (bf16_t*)(p.ws + OFF_A1);
  float* SSQ = (float*)(p.ws + OFF_SSQ);
  float* sAc = (float*)smem;
  float* sDt = sAc + 16 * 128;
  const int h = 4 * g + wid;
  const int tl = 32 * tq + r;
  const size_t trow = (size_t)gc * 128 + tl;
  f32x4 fa[2], fd[2];
#pragma unroll
  for (int i = 0; i < 2; ++i) { fa[i] = *(const f32x4*)(AC + (size_t)(gc * 128) * 16 + 4 * (tid + NT * i)); fd[i] = *(const f32x4*)(DT + (size_t)(gc * 128) * 16 + 4 * (tid + NT * i)); }
  bf16x8 cf[8];
#pragma unroll
  for (int kk = 0; kk < 8; ++kk) cf[kk] = *(const bf16x8*)(BC + (size_t)tl * 512 + 256 + g * 128 + 16 * kk + 8 * hh);
  bf16x8 bfc[8], bfn[8]; u32x2 xac[8], xan[8];
  auto ldB = [&](int stl, bf16x8 (&bf)[8], u32x2 (&xa)[8]) {
#pragma unroll
    for (int kk = 0; kk < 8; ++kk) bf[kk] = *(const bf16x8*)(BC + (size_t)(32 * stl + r) * 512 + g * 128 + 16 * kk + 8 * hh);
    const bf16_t* xb0 = XBT + (size_t)(h * 64 + r) * 128 + 32 * stl + 4 * hh;
#pragma unroll
    for (int q = 0; q < 4; ++q) { xa[q] = *(const u32x2*)(xb0 + 8 * q); xa[4 + q] = *(const u32x2*)(xb0 + 32 * 128 + 8 * q); }
  };
  ldB(0, bfc, xac);
  __syncthreads();
#pragma unroll
  for (int i = 0; i < 2; ++i) { *(f32x4*)(sAc + 4 * (tid + NT * i)) = fa[i]; *(f32x4*)(sDt + 4 * (tid + NT * i)) = fd[i]; }
  __syncthreads();
  const float acf_t = sAc[tl * 16 + h], acb_t = sAc[tl * 16 + 8 + h];
  const float Dh = p.ssd_d[layer * 8 + h];
  f32x16 y[2]; y[0] = zero16(); y[1] = zero16();
  u32x2 zz[8];
#pragma unroll
  for (int stl = 0; stl < 4; ++stl) {
    if (stl < 3) ldB(stl + 1, bfn, xan);
    else {
#pragma unroll
      for (int q = 0; q < 8; ++q) zz[q] = *(const u32x2*)(U + trow * NIN + 768 + h * 64 + 32 * (q >> 2) + 8 * (q & 3) + 4 * hh);
    }
    __builtin_amdgcn_sched_barrier(0);
    f32x16 gt = zero16();
#pragma unroll
    for (int kk = 0; kk < 8; ++kk) gt = MFMA32(bfc[kk], cf[kk], gt);
    f32x16 pt;
#pragma unroll
    for (int reg = 0; reg < 16; ++reg) {
      const int s = 32 * stl + crow(reg, hh);
      float f = 0.f;
      if (s <= tl) f += __expf(acf_t - sAc[s * 16 + h]) * sDt[s * 16 + h];
      if (s >= tl) f += __expf(acb_t - sAc[s * 16 + 8 + h]) * sDt[s * 16 + 8 + h];
      pt[reg] = gt[reg] * f + (s == tl ? Dh : 0.f);
    }
    const bf16x8 p0 = pack8<0>(pt), p1 = pack8<1>(pt);
    y[0] = MFMA32(cat44(xac[0], xac[1]), p0, y[0]); y[0] = MFMA32(cat44(xac[2], xac[3]), p1, y[0]);
    y[1] = MFMA32(cat44(xac[4], xac[5]), p0, y[1]); y[1] = MFMA32(cat44(xac[6], xac[7]), p1, y[1]);
    if (stl < 3) {
#pragma unroll
      for (int kk = 0; kk < 8; ++kk) bfc[kk] = bfn[kk];
#pragma unroll
      for (int q = 0; q < 8; ++q) xac[q] = xan[q];
    }
  }
#pragma unroll
  for (int d = 0; d < 2; ++d) {
    const bf16_t* Hb = ST + ((size_t)(d * 8 + h) * NCH + gc) * 8192;
    bf16x8 hf[2][8];
#pragma unroll
    for (int mt = 0; mt < 2; ++mt)
#pragma unroll
      for (int kk = 0; kk < 8; ++kk) hf[mt][kk] = *(const bf16x8*)(Hb + (size_t)(32 * mt + r) * 128 + 16 * kk + 8 * hh);
    f32x16 a2[2]; a2[0] = zero16(); a2[1] = zero16();
#pragma unroll
    for (int kk = 0; kk < 8; ++kk) { a2[0] = MFMA32(hf[0][kk], cf[kk], a2[0]); a2[1] = MFMA32(hf[1][kk], cf[kk], a2[1]); }
    const float e = __expf(d ? acb_t : acf_t);
#pragma unroll
    for (int mt = 0; mt < 2; ++mt)
#pragma unroll
      for (int reg = 0; reg < 16; ++reg) y[mt][reg] += e * a2[mt][reg];
  }
  float ssq = 0.f;
#pragma unroll
  for (int mt = 0; mt < 2; ++mt)
#pragma unroll
    for (int q4 = 0; q4 < 4; ++q4) {
      const int p0 = 32 * mt + 8 * q4 + 4 * hh;
      const u32x2 z2 = zz[4 * mt + q4];
      const f32x4 nw = *(const f32x4*)(p.ssd_norm_w + layer * 512 + h * 64 + p0);
      float zv[4] = {bflo(z2[0]), bfhi(z2[0]), bflo(z2[1]), bfhi(z2[1])};
      float o[4];
#pragma unroll
      for (int j = 0; j < 4; ++j) {
        const float yy = y[mt][4 * q4 + j] * siluf(zv[j]);
        ssq += yy * yy;
        o[j] = yy * nw[j];
      }
      u32x2 pk = {pack2(o[0], o[1]), pack2(o[2], o[3])};
      *(u32x2*)(Y + trow * DM + 256 + h * 64 + p0) = pk;
    }
  ssq += shx(ssq, 32, lane);
  if (hh == 0 && do_atomic) atomicAdd(SSQ + trow, ssq);
}

DI int xcd_chunk(int j, int total) {
  const int q = total >> 3, rr = total & 7, x = j & 7, off = j >> 3;
  return (x < rr ? x * (q + 1) : rr * (q + 1) + (x - rr) * q) + off;
}
DI void tile_swz(int it, int nM, int nN, int& pm, int& pn) {
  constexpr int NX = 8, WGM = 4;
  const int total = nM * nN, q = total / NX, rr = total % NX, xcd = it % NX, off = it / NX;
  const int wgid = (xcd < rr ? xcd * (q + 1) : rr * (q + 1) + (xcd - rr) * q) + off;
  const int nig = WGM * nN, gid = wgid / nig, fm = gid * WGM, gsz = min(nM - fm, WGM);
  pm = fm + (wgid % nig) % gsz; pn = (wgid % nig) / gsz;
}

enum { PH_INIT = 0, PH_NORM1, PH_INPROJ, PH_PREP, PH_MIX1, PH_SCAN, PH_S3, PH_OUTPROJ, PH_NORM2, PH_FFN1, PH_FFN2, PH_FINAL };

DI void run_phase(const Params& p, int ph, int layer, int bid, int nb, char* smem, bool last_rep = true) {
  int tix = threadIdx.x;
  asm volatile("" : "+v"(tix));
  const bool ctx_out = layer < 1;
  const float* MOD = (const float*)(p.ws + OFF_MOD);
  switch (ph) {
    case PH_INIT: {
      const int total = 192 + 16 + 64 + WC_TOTAL;
      for (int it = bid; it < total; it += nb) {
        int tx = tix; asm volatile("" : "+v"(tx));
        if (it < 192) mod_item(tx, p, it, smem);
        else if (it < 208) rope_item(tx, p, it - 192);
        else if (it < 272) {
          const f32x4* src = (const f32x4*)(p.ctx + (size_t)(it - 208) * 4096); f32x4* dst = (f32x4*)((float*)(p.ws + OFF_XC) + (size_t)(it - 208) * 4096);
#pragma unroll
          for (int i = 0; i < 4; ++i) dst[tx + NT * i] = src[tx + NT * i];
        }
        else wconv_item(tx, p, 0, it - 272, smem);
      }
    } break;
    case PH_NORM1: {
      const int total = T_ / 8 + (layer > 0 ? WC_TOTAL : 0);
      for (int it = bid; it < total; it += nb) {
        int tx = tix; asm volatile("" : "+v"(tx));
        if (it < T_ / 8) norm_item(tx, p, layer, 0, it);
        else wconv_item(tx, p, layer, it - T_ / 8, smem);
      }
    } break;
    case PH_INPROJ: {
      Epi256InProj epi{(bf16_t*)(p.ws + OFF_U), (float*)(p.ws + OFF_DTRAW)};
      const int total = 65 * 23;
      for (int it = bid; it < total; it += nb) {
        int tx = tix; asm volatile("" : "+v"(tx));
#ifdef PROBE_NOLOAD
        if (!last_rep) gemm_tile256<false, true>(tx, nullptr, (const bf16_t*)(p.ws + OFF_A1), DM, (const bf16_t*)(p.ws + OFF_WIN), DM, DM, (it / 23) * 256, (it % 23) * 128, smem, epi); else
#endif
        { int pm, pn; tile_swz(it, 65, 23, pm, pn);
          gemm_tile256<false>(tx, nullptr, (const bf16_t*)(p.ws + OFF_A1), DM, (const bf16_t*)(p.ws + OFF_WIN), DM, DM, pm * 256, pn * 128, smem, epi); }
      }
    } break;
    case PH_PREP: {
      const int n0 = 260 * 4, n1 = n0 + NCH, n2 = n1 + 780, n3 = n2 + 260 + 130;
      for (int it = bid; it < n3; it += nb) {
        int tx = tix; asm volatile("" : "+v"(tx));
        if (it < n0) conv_item(tx, p, layer, it);
        else if (it < n1) dt_item(tx, p, layer, it - n0, smem);
        else if (it < n2) qk_item(tx, p, layer, it - n1);
        else vtr_item(tx, p, it - n2);
      }
    } break;
    case PH_MIX1: {
      const int nctx = ctx_out ? 8 : 0;
      const int n0 = 512, n1 = n0 + nctx, n2 = n1 + 512, n3 = n2 + nctx, n4 = n3 + NCH * 8;
      const int nround = (n4 + nb - 1) / nb;
      for (int kk = 0; kk < nround; ++kk) {
        const int k = (bid >= (nb >> 1)) ? ((kk + 1 == nround) ? 0 : kk + 1) : kk;
        const int it = bid + k * nb;
        if (it >= n4) continue;
        int tx = tix; asm volatile("" : "+v"(tx));
        if (it < n0) gqa_item(tx, p, ((it & 3) + 4 * (it >> 3)) * 64, (it >> 2) & 1, 0, 260, smem);
        else if (it < n1) { const int j = it - n0; gqa_item(tx, p, L_ + (j >> 1) * 64, j & 1, 256, 260, smem); }
        else if (it < n2) { const int j = xcd_chunk(it - n1, 512); na_item(tx, p, layer, j >> 1, j & 1, false, smem); }
        else if (it < n3) { const int j = it - n2; na_item(tx, p, layer, j >> 1, j & 1, true, smem); }
        else { const int j = xcd_chunk(it - n3, NCH * 8); ssd_s1_item(tx, p, j >> 3, j & 7, smem); }
      }
    } break;
    case PH_SCAN: {
      for (int it = bid; it < 256; it += nb) ssd_scan_item(tix, p, it);
    } break;
    case PH_S3: {
      const int total = (ctx_out ? NCH : 128) * 8;
      for (int it = bid; it < total; it += nb) {
        int tx = tix; asm volatile("" : "+v"(tx));
        const int j = xcd_chunk(it, total);
        ssd_s3_item(tx, p, layer, j >> 3, (j >> 1) & 3, j & 1, smem, last_rep);
      }
    } break;
    case PH_OUTPROJ: {
      EpiResid epi{layer == 0 ? p.x : p.out, (const float*)(p.ws + OFF_XC), p.out, (float*)(p.ws + OFF_XC),
                   MOD + (layer * 2 + 0) * 6144 + 2 * DM, MOD + (layer * 2 + 1) * 6144 + 2 * DM};
      EpiCtxAtomic epc{(float*)(p.ws + OFF_XC), MOD + (layer * 2 + 1) * 6144 + 2 * DM};
      const int nsplit = ctx_out ? 64 : 0;
      const int total = nsplit + 128 * 8;
      for (int it = bid; it < total; it += nb) {
        int tx = tix; asm volatile("" : "+v"(tx));
        if (it < nsplit) { const int tile = it >> 2, kq = it & 3;
          gemm_tile<true>(tx, (const float*)(p.ws + OFF_SSQ), (const bf16_t*)(p.ws + OFF_A1), DM, (const bf16_t*)(p.ws + OFF_WOUT), DM, DM / 4, L_ + (tile >> 3) * 128, (tile & 7) * 128, smem, epc, kq * (DM / 4));
        } else { const int j = it - nsplit; int pm, pn; tile_swz(j, 128, 8, pm, pn);
          gemm_tile<true>(tx, (const float*)(p.ws + OFF_SSQ), (const bf16_t*)(p.ws + OFF_A1), DM, (const bf16_t*)(p.ws + OFF_WOUT), DM, DM, pm * 128, pn * 128, smem, epi);
        }
      }
    } break;
    case PH_NORM2: {
      const int total = (ctx_out ? T_ : L_) / 8;
      for (int it = bid; it < total; it += nb) norm_item(tix, p, layer, 1, it);
    } break;
    case PH_FFN1: {
      Epi256SwiGLU epi{(bf16_t*)(p.ws + OFF_U)};
      const int total = (ctx_out ? 65 : 64) * 44;
      for (int it = bid; it < total; it += nb) {
        int tx = tix; asm volatile("" : "+v"(tx));
#ifdef PROBE_NOLOAD
        if (!last_rep) gemm_tile256<false, true>(tx, nullptr, (const bf16_t*)(p.ws + OFF_A1), DM, (const bf16_t*)(p.ws + OFF_WGU), DM, DM, (it / 44) * 256, (it % 44) * 128, smem, epi); else
#endif
        { int pm, pn; tile_swz(it, ctx_out ? 65 : 64, 44, pm, pn);
          gemm_tile256<false>(tx, nullptr, (const bf16_t*)(p.ws + OFF_A1), DM, (const bf16_t*)(p.ws + OFF_WGU), DM, DM, pm * 256, pn * 128, smem, epi); }
      }
    } break;
    case PH_FFN2: {
      Epi256Resid epi{p.out, p.out, MOD + (layer * 2 + 0) * 6144 + 5 * DM};
      Epi256CtxAtomic epc{(float*)(p.ws + OFF_XC), MOD + (layer * 2 + 1) * 6144 + 5 * DM};
      const int nsplit = ctx_out ? 32 : 0;
      const int total = nsplit + 64 * 8;
      for (int it = bid; it < total; it += nb) {
        int tx = tix; asm volatile("" : "+v"(tx));
        if (it < nsplit) { const int tile = it >> 2, kq = it & 3;
          gemm_tile256<false>(tx, nullptr, (const bf16_t*)(p.ws + OFF_U), FH, (const bf16_t*)(p.ws + OFF_WD), FH, FH / 4, L_, tile * 128, smem, epc, kq * (FH / 4));
        } else { const int j = it - nsplit; int pm, pn; tile_swz(j, 64, 8, pm, pn);
          gemm_tile256<false>(tx, nullptr, (const bf16_t*)(p.ws + OFF_U), FH, (const bf16_t*)(p.ws + OFF_WD), FH, FH, pm * 256, pn * 128, smem, epi);
        }
      }
    } break;
    case PH_FINAL: {
      for (int it = bid; it < L_ / 8; it += nb) norm_item(tix, p, 1, 2, it);
    } break;
  }
}

#define XB_TMO      128
#define XB_XCNT(j)  (256  + 64 * (j))
#define XB_XSUB(j)  (1280 + 64 * (j))
#define XB_XGEN(j)  (2304 + 64 * (j))
#define XB_TOP      3328
#define XB_TOPGEN   3392
#define XB_SPIN_CAP (1u << 22)
DI unsigned xb_ld(unsigned* p) { return __hip_atomic_load(p, __ATOMIC_RELAXED, __HIP_MEMORY_SCOPE_AGENT); }
DI unsigned xb_add(unsigned* p, unsigned v) { return __hip_atomic_fetch_add(p, v, __ATOMIC_RELAXED, __HIP_MEMORY_SCOPE_AGENT); }
DI unsigned xb_xcc_id() { return (unsigned)__builtin_amdgcn_s_getreg((3 << 11) | 20) & 0xFu; }
#define XB_SPIN(cond, bar) do { unsigned _sp = 0; while (cond) { __builtin_amdgcn_s_sleep(1); \
    if ((++_sp & 255u) == 0u) { if (xb_ld(&(bar)[XB_TMO])) break; if (_sp > XB_SPIN_CAP) { atomicAdd(&(bar)[XB_TMO], 1u); break; } } } } while (0)
DI void xb_complete(unsigned* bar, unsigned x, unsigned G, unsigned& nloc, unsigned& nx) {
  unsigned sum, cnt, mine, sp = 0u;
  for (;;) {
    sum = 0u; cnt = 0u; mine = 0u;
#pragma unroll
    for (unsigned j = 0; j < 16; ++j) { const unsigned c = xb_ld(&bar[XB_XCNT(j)]); sum += c; cnt += (c > 0u) ? 1u : 0u; mine = (j == x) ? c : mine; }
    if (sum == G) break;
    __builtin_amdgcn_s_sleep(1);
    if ((++sp & 255u) == 0u) { if (xb_ld(&bar[XB_TMO])) break; if (sp > XB_SPIN_CAP) { atomicAdd(&bar[XB_TMO], 1u); break; } }
  }
  nloc = mine > 0u ? mine : 1u; nx = cnt > 0u ? cnt : 1u;
}
DI void grid_barrier(unsigned* bar, volatile unsigned* st, unsigned x, unsigned G) {
  asm volatile("s_waitcnt vmcnt(0)" ::: "memory");
  __syncthreads();
  if (threadIdx.x == 0) {
    __builtin_amdgcn_s_waitcnt(0);
    unsigned nloc = st[0], nx = st[1];
    if (nloc == 0u) { xb_complete(bar, x, G, nloc, nx); st[0] = nloc; st[1] = nx; }
    const unsigned old = xb_add(&bar[XB_XSUB(x)], 1u);
    const unsigned gen = old / nloc;
    if (old + 1u == (gen + 1u) * nloc) {
      __builtin_amdgcn_fence(__ATOMIC_RELEASE, "agent");
      asm volatile("s_waitcnt vmcnt(0)" ::: "memory");
      const unsigned og = xb_add(&bar[XB_TOP], 1u);
      const unsigned tg = og / nx;
      if (og + 1u == (tg + 1u) * nx) xb_add(&bar[XB_TOPGEN], 1u);
      else XB_SPIN(xb_ld(&bar[XB_TOPGEN]) == tg, bar);
      __builtin_amdgcn_fence(__ATOMIC_ACQUIRE, "agent");
      xb_add(&bar[XB_XGEN(x)], 1u);
      asm volatile("s_waitcnt vmcnt(0)" ::: "memory");
    } else {
      XB_SPIN(xb_ld(&bar[XB_XGEN(x)]) == gen, bar);
      __builtin_amdgcn_fence(__ATOMIC_ACQUIRE, "agent");
      asm volatile("s_waitcnt vmcnt(0)" ::: "memory");
    }
  }
  __syncthreads();
}

#if MULTI_LAUNCH
extern __shared__ __attribute__((aligned(16))) char smem[];
template <int PH> __global__ void __launch_bounds__(NT, 2) phase_kernel(Params p, int layer) {
  run_phase(p, PH, layer, blockIdx.x, gridDim.x, smem);
}
template <int PH> static void launch_phase(const Params& p, int layer, hipStream_t stream) {
  (void)hipFuncSetAttribute((const void*)phase_kernel<PH>, hipFuncAttributeMaxDynamicSharedMemorySize, SMEM_BYTES);
  phase_kernel<PH><<<1024, NT, SMEM_BYTES, stream>>>(p, layer);
}
#else
extern __shared__ __attribute__((aligned(16))) char smem[];
__global__ void __launch_bounds__(NT, 2) mega_kernel(Params p) {
  cg::grid_group grid = cg::this_grid();
  const int bid = blockIdx.x, nb = gridDim.x;
  unsigned* bar = (unsigned*)(p.ws + OFF_BAR);
  volatile unsigned* st = (volatile unsigned*)(smem + SMEM_BYTES);
  if (threadIdx.x == 0) { st[0] = 0u; st[1] = 0u; }
  const unsigned xcc = xb_xcc_id();
  if (threadIdx.x == 0) (void)xb_add(&bar[XB_XCNT(xcc)], 1u);
  if (p.ws == nullptr) grid.sync();
  run_phase(p, PH_INIT, 0, bid, nb, smem);
  grid_barrier(bar, st, xcc, (unsigned)nb);
  for (int layer = 0; layer < 2; ++layer) {
    for (int ph = PH_NORM1; ph <= PH_FFN2; ++ph) {
#ifdef DUP_MASK
      const int reps = 1 + ((DUP_MASK >> ph) & 1);
#else
      const int reps = 1;
#endif
#pragma unroll 1
      for (int rep = 0; rep < reps; ++rep) {
        run_phase(p, ph, layer, bid, nb, smem, rep == reps - 1);
        grid_barrier(bar, st, xcc, (unsigned)nb);
      }
    }
  }
#ifdef EXTRA_SYNCS
#pragma unroll 1
  for (int i = 0; i < EXTRA_SYNCS; ++i) grid_barrier(bar, st, xcc, (unsigned)nb);
#endif
  run_phase(p, PH_FINAL, 1, bid, nb, smem);
}
#endif

extern "C" void kernel_launch(void* const* d_in, const int* in_sizes, int n_in, void* d_out, int out_size, void* d_ws, size_t ws_size,
                              hipStream_t stream) {
  Params p{};
  const float** pf = (const float**)&p;
  for (int i = 0; i < 23; ++i) pf[i] = (const float*)d_in[i];
  p.out = (float*)d_out;
  p.ws = (char*)d_ws;
#if MULTI_LAUNCH
  launch_phase<PH_INIT>(p, 0, stream);
  for (int layer = 0; layer < 2; ++layer) {
    launch_phase<PH_NORM1>(p, layer, stream); launch_phase<PH_INPROJ>(p, layer, stream); launch_phase<PH_PREP>(p, layer, stream);
    launch_phase<PH_MIX1>(p, layer, stream); launch_phase<PH_SCAN>(p, layer, stream); launch_phase<PH_S3>(p, layer, stream);
    launch_phase<PH_OUTPROJ>(p, layer, stream); launch_phase<PH_NORM2>(p, layer, stream); launch_phase<PH_FFN1>(p, layer, stream);
    launch_phase<PH_FFN2>(p, layer, stream);
  }
  launch_phase<PH_FINAL>(p, 1, stream);
#else
  static int grid_blocks = 0;
  if (!grid_blocks) {
    int dev = 0, cus = 0, per_cu = 0;
    (void)hipGetDevice(&dev);
    (void)hipDeviceGetAttribute(&cus, hipDeviceAttributeMultiprocessorCount, dev);
    (void)hipFuncSetAttribute((const void*)mega_kernel, hipFuncAttributeMaxDynamicSharedMemorySize, SMEM_BYTES + 16);
    (void)hipOccupancyMaxActiveBlocksPerMultiprocessor(&per_cu, mega_kernel, NT, SMEM_BYTES + 16);
    if (per_cu > 2) per_cu = 2;
    grid_blocks = cus * per_cu;
  }
  (void)hipMemsetAsync((char*)d_ws + OFF_BAR, 0, 64 * 256, stream);
  void* args[] = {&p};
  hipError_t e = hipLaunchCooperativeKernel((void*)mega_kernel, dim3(grid_blocks), dim3(NT), args, SMEM_BYTES + 16, stream);
  if (e != hipSuccess) fprintf(stderr, "cooperative launch failed: %s (grid %d)\n", hipGetErrorString(e), grid_blocks);
#endif
}
```
